# Optimizing an MI355X kernel written in HIP

```python
import math
import jax, jax.numpy as jnp
from jax import lax
import numpy as np

D_MODEL = 1024
BATCH = 4
SEQ = 4096
DEPTH = 4

GRID_W = 64
CTX_LEN = 256
CONV_WIDTH = 3
D_CONV = 512
N_DIFF_HEADS = 4
DIFF_QK_DIM = 64
DIFF_V_DIM = 128
D_ATTN = N_DIFF_HEADS * DIFF_V_DIM
N_FOURIER_GROUPS = 8
FOURIER_GROUP = D_MODEL // N_FOURIER_GROUPS
D_FF = 4 * D_MODEL
Q_BLOCK = 128
ROPE_BASE = 10000.0
LN_EPS = 1e-6
SUBLN_EPS = 1e-5
DEEPNORM_ALPHA = (2.0 * DEPTH) ** 0.25
DEEPNORM_BETA = (8.0 * DEPTH) ** -0.25
N_EVEN = (DEPTH + 1) // 2
N_ODD = DEPTH // 2
COL_CONV = 3 * D_CONV
COL_Q = N_DIFF_HEADS * 2 * DIFF_QK_DIM
COL_K = N_DIFF_HEADS * 2 * DIFF_QK_DIM
COL_V = D_ATTN
Q0 = COL_CONV
K0 = Q0 + COL_Q
V0 = K0 + COL_K
D_IN = V0 + COL_V

kernel_name = 'hybrid_conv_diffattn_fourier_dit'


def layer_norm(x):
    xf = x.astype(jnp.float32)
    mu = jnp.mean(xf, axis=-1, keepdims=True)
    var = jnp.mean(jnp.square(xf - mu), axis=-1, keepdims=True)
    return ((xf - mu) * lax.rsqrt(var + LN_EPS)).astype(x.dtype)


def layer_norm_affine(x, g, b):
    xf = x.astype(jnp.float32)
    mu = jnp.mean(xf, axis=-1, keepdims=True)
    var = jnp.mean(jnp.square(xf - mu), axis=-1, keepdims=True)
    y = (xf - mu) * lax.rsqrt(var + LN_EPS) * g.astype(jnp.float32) + b.astype(jnp.float32)
    return y.astype(x.dtype)


def modulation(cond, w, b):
    return jnp.split(jax.nn.silu(cond) @ w + b, 6, axis=-1)


def modulate(h, shift, scale):
    return layer_norm(h) * (1.0 + scale) + shift


def post_norm_residual(h, y, gate, g, b):
    return layer_norm_affine(DEEPNORM_ALPHA * h + gate * y, g, b)


def rope_1d(x, pos):
    half = x.shape[-1] // 2
    inv = ROPE_BASE ** (-jnp.arange(half, dtype=jnp.float32) / half)
    ang = pos.astype(jnp.float32)[:, None] * inv[None, :]
    cos = jnp.cos(ang)[:, None, None, :].astype(x.dtype)
    sin = jnp.sin(ang)[:, None, None, :].astype(x.dtype)
    x1, x2 = x[..., :half], x[..., half:]
    return jnp.concatenate([x1 * cos - x2 * sin, x1 * sin + x2 * cos], axis=-1)


def rope_2d(x, row, col):
    d = x.shape[-1] // 2
    return jnp.concatenate([rope_1d(x[..., :d], row), rope_1d(x[..., d:], col)], axis=-1)


def short_conv(u, w):
    n = u.shape[1]
    pad = CONV_WIDTH // 2
    up = jnp.pad(u, ((0, 0), (pad, pad), (0, 0)))
    return sum(up[:, t:t + n] * w[t] for t in range(CONV_WIDTH))


def conv_mixer(p, w):
    gb, gc, v = jnp.split(p, 3, axis=-1)
    return gb * short_conv(gc * v, w)


def heads_qk(p):
    return p.reshape(p.shape[0], p.shape[1], N_DIFF_HEADS, 2, DIFF_QK_DIM)


def heads_v(p):
    return p.reshape(p.shape[0], p.shape[1], N_DIFF_HEADS, DIFF_V_DIM)


def diff_attend(q, k, v, lam):
    s = jnp.einsum('bqhcd,bkhcd->bhcqk', q, k).astype(jnp.float32) * (DIFF_QK_DIM ** -0.5)
    p = jax.nn.softmax(s, axis=-1)
    pd = (p[:, :, 0] - lam * p[:, :, 1]).astype(v.dtype)
    return jnp.einsum('bhqk,bkhd->bqhd', pd, v)


def diff_attention_blocks(q, k, v, lam):
    b, n = q.shape[0], q.shape[1]
    nb = n // Q_BLOCK
    qb = q.reshape(b, nb, Q_BLOCK, N_DIFF_HEADS, 2, DIFF_QK_DIM).transpose(1, 0, 2, 3, 4, 5)
    out = lax.map(lambda blk: diff_attend(blk, k, v, lam), qb)
    return out.transpose(1, 0, 2, 3, 4).reshape(b, n, N_DIFF_HEADS, DIFF_V_DIM)


def sub_ln(o, g, lam_init):
    of = o.astype(jnp.float32)
    y = of * lax.rsqrt(jnp.mean(of * of, axis=-1, keepdims=True) + SUBLN_EPS)
    y = y * g.astype(jnp.float32) * (1.0 - lam_init)
    return y.reshape(o.shape[0], o.shape[1], D_ATTN).astype(o.dtype)


def fourier_mix(u):
    b, n, _ = u.shape
    ug = u.astype(jnp.float32).reshape(b, n, N_FOURIER_GROUPS, FOURIER_GROUP)
    f = jnp.fft.fft2(ug, axes=(1, 3), norm='ortho').real
    return f.reshape(b, n, D_MODEL).astype(u.dtype)


def sq_relu_mlp(u, w1, w2):
    return jnp.square(jax.nn.relu(u @ w1)) @ w2


def setup_inputs(seed: int = 0) -> dict:
    key = jax.random.key(seed)
    ks = jax.random.split(key, 16)
    f32 = jnp.float32

    def nrm(k, shape, s):
        return s * jax.random.normal(k, shape, f32)

    return {
        'x': nrm(ks[0], (BATCH, SEQ, D_MODEL), 1.0),
        'c': nrm(ks[1], (BATCH, D_MODEL), 1.0),
        'ctx': nrm(ks[2], (BATCH, CTX_LEN, D_MODEL), 1.0),
        'c_ctx': nrm(ks[3], (D_MODEL,), 1.0),
        'ada_w': nrm(ks[4], (DEPTH, D_MODEL, 6 * D_MODEL), 0.5 * D_MODEL ** -0.5),
        'ada_b': nrm(ks[5], (DEPTH, 6 * D_MODEL), 0.01),
        'ln_g': 1.0 + nrm(ks[6], (DEPTH, 2, D_MODEL), 0.05),
        'ln_b': nrm(ks[7], (DEPTH, 2, D_MODEL), 0.02),
        'mlp_w1': nrm(ks[8], (DEPTH, D_MODEL, D_FF), D_MODEL ** -0.5),
        'mlp_w2': nrm(ks[9], (DEPTH, D_FF, D_MODEL), DEEPNORM_BETA * D_FF ** -0.5),
        'w_in': nrm(ks[10], (N_EVEN, D_MODEL, D_IN), D_MODEL ** -0.5),
        'conv_w': nrm(ks[11], (N_EVEN, CONV_WIDTH, D_CONV), CONV_WIDTH ** -0.5),
        'lambda_qk': nrm(ks[12], (N_EVEN, 4, DIFF_QK_DIM), 0.1),
        'subln_g': 1.0 + nrm(ks[13], (N_EVEN, DIFF_V_DIM), 0.05),
        'w_out_mix': nrm(ks[14], (N_EVEN, D_CONV + D_ATTN, D_MODEL), DEEPNORM_BETA * (D_CONV + D_ATTN) ** -0.5),
        'w_out_fourier': nrm(ks[15], (N_ODD, D_MODEL, D_MODEL), DEEPNORM_BETA * D_MODEL ** -0.5),
    }


def reference(x, c, ctx, c_ctx, ada_w, ada_b, ln_g, ln_b, mlp_w1, mlp_w2, w_in, conv_w, lambda_qk, subln_g, w_out_mix, w_out_fourier):
    n = x.shape[1]
    rows = n // GRID_W
    row = jnp.repeat(jnp.arange(rows, dtype=jnp.int32), GRID_W)
    col = jnp.tile(jnp.arange(GRID_W, dtype=jnp.int32), rows)
    last_attn = 2 * ((DEPTH - 1) // 2)
    cond_lat = c[:, None, :]
    cond_ctx = c_ctx[None, None, :]
    h, hc = x, ctx
    for i in range(DEPTH):
        j = i // 2
        update_ctx = i < last_attn
        sh1, sc1, g1, sh2, sc2, g2 = modulation(cond_lat, ada_w[i], ada_b[i])
        u = modulate(h, sh1, sc1)
        if update_ctx or i == last_attn:
            mc = modulation(cond_ctx, ada_w[i], ada_b[i])
            uc = modulate(hc, mc[0], mc[1])
        if i % 2 == 0:
            lam_init = 0.8 - 0.6 * math.exp(-0.3 * i)
            lq = lambda_qk[j].astype(jnp.float32)
            lam = jnp.exp(jnp.sum(lq[0] * lq[1])) - jnp.exp(jnp.sum(lq[2] * lq[3])) + lam_init
            p = u @ w_in[j]
            q = rope_2d(heads_qk(p[..., Q0:K0]), row, col)
            k = rope_2d(heads_qk(p[..., K0:V0]), row, col)
            v = heads_v(p[..., V0:])
            if update_ctx:
                pc = uc @ w_in[j]
                kvc = pc[..., K0:]
            else:
                kvc = uc @ w_in[j][:, K0:]
            kc = heads_qk(kvc[..., :COL_K])
            vc = heads_v(kvc[..., COL_K:])
            k_all = jnp.concatenate([k, kc], axis=1)
            v_all = jnp.concatenate([v, vc], axis=1)
            o = diff_attention_blocks(q, k_all, v_all, lam)
            y = jnp.concatenate([conv_mixer(p[..., :COL_CONV], conv_w[j]), sub_ln(o, subln_g[j], lam_init)], axis=-1) @ w_out_mix[j]
            if update_ctx:
                oc = diff_attend(heads_qk(pc[..., Q0:K0]), kc, vc, lam)
                yc = jnp.concatenate([conv_mixer(pc[..., :COL_CONV], conv_w[j]), sub_ln(oc, subln_g[j], lam_init)], axis=-1) @ w_out_mix[j]
        else:
            y = fourier_mix(u) @ w_out_fourier[j]
            if update_ctx:
                yc = fourier_mix(uc) @ w_out_fourier[j]
        h = post_norm_residual(h, y, g1, ln_g[i, 0], ln_b[i, 0])
        h = post_norm_residual(h, sq_relu_mlp(modulate(h, sh2, sc2), mlp_w1[i], mlp_w2[i]), g2, ln_g[i, 1], ln_b[i, 1])
        if update_ctx:
            hc = post_norm_residual(hc, yc, mc[2], ln_g[i, 0], ln_b[i, 0])
            hc = post_norm_residual(hc, sq_relu_mlp(modulate(hc, mc[3], mc[4]), mlp_w1[i], mlp_w2[i]), mc[5], ln_g[i, 1], ln_b[i, 1])
    return h
```

```cpp
#include <hip/hip_runtime.h>
#include <hip/hip_cooperative_groups.h>
#include <cstdio>
namespace cg = cooperative_groups;
#ifndef REP_P0
#define REP_P0 1
#endif
#ifndef REP_ATT
#define REP_ATT 1
#endif
#ifndef REP_GEMM
#define REP_GEMM 1
#endif
#ifndef REP_SYNC
#define REP_SYNC 1
#endif

#define LAS __attribute__((address_space(3)))
#define DI __device__ __forceinline__
typedef unsigned short bf16_t;
typedef short bf16x8 __attribute__((ext_vector_type(8)));
typedef short s16x4 __attribute__((ext_vector_type(4)));
typedef float f32x4 __attribute__((ext_vector_type(4)));
typedef float f32x2 __attribute__((ext_vector_type(2)));
typedef float f32x16 __attribute__((ext_vector_type(16)));
typedef unsigned u32x4 __attribute__((ext_vector_type(4)));
typedef unsigned u32x2 __attribute__((ext_vector_type(2)));
typedef __bf16 bf2_t __attribute__((ext_vector_type(2)));

constexpr int TPB = 4352;
constexpr int NROW = 17408;
constexpr float ALPHA = 1.681792830507429f;

constexpr size_t WS_WIN = 0;
constexpr size_t WS_W1 = WS_WIN + 12582912;
constexpr size_t WS_W2 = WS_W1 + 33554432;
constexpr size_t WS_WOM = WS_W2 + 33554432;
constexpr size_t WS_W12 = WS_WOM + 4194304;
constexpr size_t WS_H = WS_W12 + 8388608;
constexpr size_t WS_U = WS_H + 71303168;
constexpr size_t WS_Y = WS_U + 35651584;
constexpr size_t WS_BIG = WS_Y + 35651584;
constexpr size_t WS_P = WS_BIG;
constexpr size_t WS_QB = WS_BIG + 53477376;
constexpr size_t WS_KB = WS_QB + 17825792;
constexpr size_t WS_VT = WS_KB + 17825792;
constexpr size_t WS_MIX = WS_VT + 17825792;
constexpr size_t WS_HID = WS_BIG;
constexpr size_t WS_ZT = WS_BIG;
constexpr size_t WS_ZTC = WS_BIG + 67108864;
constexpr size_t WS_WT = WS_ZTC + 4194304;
constexpr size_t WS_MODP = WS_BIG + 142606336;
constexpr size_t WS_MOD = WS_MODP + 7864320;
constexpr size_t WS_ROPE = WS_MOD + 491520;
constexpr size_t WS_DN256 = WS_ROPE + 8192;
constexpr size_t WS_BAR = WS_DN256 + 262144;
constexpr size_t WS_DN2 = WS_BAR + 16384;
constexpr size_t WS_END = WS_DN2 + 262144;

struct Params {
  const float *x, *c, *ctx, *c_ctx, *ada_w, *ada_b, *ln_g, *ln_b, *w1, *w2, *w_in, *conv_w, *lam_qk, *subln_g, *w_out_mix, *w_out_f;
  float* out; unsigned char* ws;
};

DI unsigned pk2(float a, float b) { f32x2 v = {a, b}; bf2_t r = __builtin_convertvector(v, bf2_t); return __builtin_bit_cast(unsigned, r); }
DI float bflo(unsigned w) { return __uint_as_float(w << 16); }
DI float bfhi(unsigned w) { return __uint_as_float(w & 0xffff0000u); }
DI float wave_sum(float v) {
#pragma unroll
  for (int o = 32; o >= 1; o >>= 1) v += __shfl_xor(v, o);
  return v;
}


#define XB_TMO      128
#define XB_XCNT(j)  (256  + 64 * (j))
#define XB_XSUB(j)  (1280 + 64 * (j))
#define XB_XGEN(j)  (2304 + 64 * (j))
#define XB_TOP      3328
#define XB_TOPGEN   3392
#define XCD_BAR_WORDS 3456
#define XB_SPIN_CAP (1u << 20)
DI unsigned xb_ld(unsigned* p)              { return __hip_atomic_load(p, __ATOMIC_RELAXED, __HIP_MEMORY_SCOPE_AGENT); }
DI unsigned xb_add(unsigned* p, unsigned v) { return __hip_atomic_fetch_add(p, v, __ATOMIC_RELAXED, __HIP_MEMORY_SCOPE_AGENT); }
DI unsigned xb_xcc_id() { return (unsigned)__builtin_amdgcn_s_getreg((3 << 11) | 20) & 0xFu; }
#define XB_SPIN(cond, bar) do { unsigned _sp = 0; while (cond) { __builtin_amdgcn_s_sleep(1); \
    if ((++_sp & 255u) == 0u) { if (xb_ld(&(bar)[XB_TMO])) break; if (_sp > XB_SPIN_CAP) { atomicAdd(&(bar)[XB_TMO], 1u); break; } } } } while (0)
struct XcdBarrier { unsigned* bar; unsigned x; volatile LAS unsigned* st; };
DI XcdBarrier xcd_barrier_post(unsigned* bar, volatile LAS unsigned* st) {
  XcdBarrier b; b.bar = bar; b.x = xb_xcc_id(); b.st = st;
  if (threadIdx.x == 0) (void)xb_add(&bar[XB_XCNT(b.x)], 1u);
  return b;
}
DI void xcd_barrier_complete(unsigned* bar, unsigned x, unsigned& nloc, unsigned& nx) {
  const unsigned G = gridDim.x * gridDim.y * gridDim.z;
  unsigned sum, cnt, mine, sp = 0u;
  for (;;) {
    sum = 0u; cnt = 0u; mine = 0u;
#pragma unroll
    for (unsigned j = 0; j < 16; ++j) { const unsigned c = xb_ld(&bar[XB_XCNT(j)]); sum += c; cnt += (c > 0u) ? 1u : 0u; mine = (j == x) ? c : mine; }
    if (sum == G) break;
    __builtin_amdgcn_s_sleep(1);
    if ((++sp & 255u) == 0u) { if (xb_ld(&bar[XB_TMO])) break; if (sp > XB_SPIN_CAP) { atomicAdd(&bar[XB_TMO], 1u); break; } }
  }
  nloc = mine > 0u ? mine : 1u; nx = cnt > 0u ? cnt : 1u;
}
DI void xcd_barrier(const XcdBarrier& b) {
  asm volatile("s_waitcnt vmcnt(0)" ::: "memory");
  __syncthreads();
  if (threadIdx.x == 0) {
    unsigned* bar = b.bar;
    __builtin_amdgcn_s_waitcnt(0);
    unsigned nloc = b.st[0], nx = b.st[1];
    if (nloc == 0u) { xcd_barrier_complete(bar, b.x, nloc, nx); b.st[0] = nloc; b.st[1] = nx; }
    const unsigned old = xb_add(&bar[XB_XSUB(b.x)], 1u);
    const unsigned gen = old / nloc;
    if (old + 1u == (gen + 1u) * nloc) {
      __builtin_amdgcn_fence(__ATOMIC_RELEASE, "agent");
      asm volatile("s_waitcnt vmcnt(0)" ::: "memory");
      const unsigned og = xb_add(&bar[XB_TOP], 1u);
      const unsigned tg = og / nx;
      if (og + 1u == (tg + 1u) * nx) xb_add(&bar[XB_TOPGEN], 1u);
      else XB_SPIN(xb_ld(&bar[XB_TOPGEN]) == tg, bar);
      __builtin_amdgcn_fence(__ATOMIC_ACQUIRE, "agent");
      xb_add(&bar[XB_XGEN(b.x)], 1u);
      asm volatile("s_waitcnt vmcnt(0)" ::: "memory");
    } else {
      XB_SPIN(xb_ld(&bar[XB_XGEN(b.x)]) == gen, bar);
      __builtin_amdgcn_fence(__ATOMIC_ACQUIRE, "agent");
      asm volatile("s_waitcnt vmcnt(0)" ::: "memory");
    }
  }
  __syncthreads();
}

constexpr int BM = 256, BK = 64, HALF = 128, HTB = HALF * BK * 2, STAGE_BYTES = 8 * HTB, NXCD = 8, WGM = 8;
DI int lds_byte(int r, int c) { const int st = (r >> 4) * 2 + (c >> 5), rr = r & 15, cc = c & 31, ob = rr * 64 + cc * 2; return st * 1024 + (ob ^ (((ob >> 9) & 1) << 5)); }
DI void stage_rc(int b, int& R, int& C) { const int st = b / 1024, sb = b % 1024, swz = sb ^ (((sb >> 9) & 1) << 5); R = (st >> 1) * 16 + swz / 64; C = (st & 1) * 32 + (swz % 64) / 2; }
DI int perm32(int rho) { const int n = rho >> 4, i = rho & 15; return 8 * (i >> 2) + 4 * n + (i & 3); }

struct Unit { int pm, pn; };
struct Gemm { const bf16_t* A; const bf16_t* Bt; int M, N, K; int mode; int a_mod; size_t bstride; int lda, ldb; };

struct StaticOrder {
  int nM, nN, nwg, G, c;
  DI void init(int M, int N, int G_, int c_) { nM = M / BM; nN = N / BM; nwg = nM * nN; G = G_; c = c_; }
  DI bool next(int i, Unit& u) const {
    const long L = (long)i * G + c; if (L >= nwg) return false;
    int wgid = (int)L; { const int q = nwg / NXCD, r = nwg % NXCD, xcd = wgid % NXCD, off = wgid / NXCD; wgid = (xcd < r ? xcd * (q + 1) : r * (q + 1) + (xcd - r) * q) + off; }
    const int nig = WGM * nN, gid = wgid / nig, fm = gid * WGM, gsz = (nM - fm) < WGM ? (nM - fm) : WGM;
    u.pm = fm + ((wgid % nig) % gsz); u.pn = (wgid % nig) / gsz; return true;
  }
};

DI void unit_ptrs(const Gemm& g, const Unit& v, size_t tstepA, size_t tstepB, const char*& cA, const char*& cB, Unit& real) {
  int pm = v.pm, pn = v.pn, pa = v.pm, pb = v.pn; size_t boff = 0, aoff = 0;
  if (g.mode == 1) { pm = pm + pm / 16; pa = pm; }
  else if (g.mode == 2) { pn = pn + pn / 16; pb = pn; }
  else if (g.mode == 3) { pa = pm % g.a_mod; boff = (size_t)(pm / g.a_mod) * g.bstride; }
  else if (g.mode == 4) { const int bb = pm / g.a_mod, ks = pm % g.a_mod; pa = 0; aoff = ((size_t)(bb * TPB + 4096) * g.lda + (size_t)ks * 256) * 2; boff = (size_t)ks * 512; }
  cA = (const char*)g.A + aoff + (size_t)pa * tstepA; cB = (const char*)g.Bt + boff + (size_t)pb * tstepB; real.pm = pm; real.pn = pn;
}

template <class Epi>
DI void gemm_phase(LAS unsigned char* lds, const Gemm g, const Epi& E) {
  int tid = threadIdx.x; asm volatile("" : "+v"(tid));
  const int wid = __builtin_amdgcn_readfirstlane(tid >> 6), lane = tid & 63, wr = wid >> 2, wc = wid & 3, fr = lane & 15, fq = lane >> 4;
  const int K = g.K, nt = K / BK;
  StaticOrder S; S.init(g.M, g.N, (int)gridDim.x, (int)blockIdx.x);
  unsigned voffA[2], voffB[2];
#pragma unroll
  for (int i = 0; i < 2; ++i) { int R, C; stage_rc(tid * 16 + i * 8192, R, C); const int Rb = Epi::PERM ? ((R & ~31) + perm32(R & 31)) : R;
    voffA[i] = (unsigned)(R * g.lda + C) * 2u; voffB[i] = (unsigned)(Rb * g.ldb + C) * 2u; }
  const size_t kstep = (size_t)(BK * 2);
  const size_t hstepA = (size_t)HALF * g.lda * 2, hstepB = (size_t)HALF * g.ldb * 2;
  const size_t tstepA = 2 * hstepA, tstepB = 2 * hstepB;
  const unsigned ldsw = (unsigned)wid * 1024u;
  const int aoff = lds_byte(wr * 64 + fr, fq * 8), boff = lds_byte(wc * 32 + fr, fq * 8);
#define PG8_SA(b, h) (((b) * 2 + (h)) * HTB)
#define PG8_SB(b, h) ((4 + (b) * 2 + (h)) * HTB)
#define PG8_STAGE(bufoff, gbase, voff) do { _Pragma("unroll") for (int _i = 0; _i < 2; ++_i) \
        __builtin_amdgcn_global_load_lds((const unsigned*)((const char*)(gbase) + (voff)[_i]), (LAS unsigned*)(lds + (bufoff) + ldsw + _i * 8192), 16, 0, 0); } while (0)
#define PG8_LDA(dst, b, h) do { _Pragma("unroll") for (int m = 0; m < 4; ++m) _Pragma("unroll") for (int k = 0; k < 2; ++k) dst[m][k] = *(const LAS bf16x8*)(lds + PG8_SA(b, h) + aoff + m * 2048 + k * 1024); } while (0)
#define PG8_LDB(dst, b, h) do { _Pragma("unroll") for (int n = 0; n < 2; ++n) _Pragma("unroll") for (int k = 0; k < 2; ++k) dst[n][k] = *(const LAS bf16x8*)(lds + PG8_SB(b, h) + boff + n * 2048 + k * 1024); } while (0)
#define PG8_MMA(ai, bj, At, Bt) do { __builtin_amdgcn_s_setprio(1); _Pragma("unroll") for (int m = 0; m < 4; ++m) _Pragma("unroll") for (int n = 0; n < 2; ++n) _Pragma("unroll") for (int k = 0; k < 2; ++k) \
        acc[ai][bj][m][n] = __builtin_amdgcn_mfma_f32_16x16x32_bf16(Bt[n][k], At[m][k], acc[ai][bj][m][n], 0, 0, 0); __builtin_amdgcn_s_setprio(0); } while (0)
#define PG8_WAIT_V(n) asm volatile("s_waitcnt vmcnt(" #n ")" ::: "memory")
#define PG8_WAIT_L(n) asm volatile("s_waitcnt lgkmcnt(" #n ")" ::: "memory")
#define PG8_BAR __builtin_amdgcn_s_barrier()
#define PG8_SCHED __builtin_amdgcn_sched_barrier(0)
  Unit cur, nxt, curR, nxtR; int ui = 0;
  if (!S.next(0, cur)) return;
  f32x4 acc[2][2][4][2];
#pragma unroll
  for (int a = 0; a < 2; ++a)
#pragma unroll
    for (int b = 0; b < 2; ++b)
#pragma unroll
      for (int m = 0; m < 4; ++m)
#pragma unroll
        for (int n = 0; n < 2; ++n) acc[a][b][m][n] = (f32x4){0.f, 0.f, 0.f, 0.f};
  bf16x8 At[4][2], B0[2][2], B1[2][2];
  const char* cA; const char* cB;
  unit_ptrs(g, cur, tstepA, tstepB, cA, cB, curR);
  PG8_STAGE(PG8_SB(0, 0), cB, voffB); PG8_STAGE(PG8_SA(0, 0), cA, voffA); PG8_STAGE(PG8_SB(0, 1), cB + hstepB, voffB); PG8_STAGE(PG8_SA(0, 1), cA + hstepA, voffA);
  if (wr == 1) PG8_BAR;
  PG8_WAIT_V(4); PG8_BAR;
  PG8_STAGE(PG8_SB(1, 0), cB + kstep, voffB); PG8_STAGE(PG8_SA(1, 0), cA + kstep, voffA); PG8_STAGE(PG8_SB(1, 1), cB + hstepB + kstep, voffB);
  PG8_WAIT_V(6); PG8_BAR;
  for (;;) {
    const bool has_next = S.next(ui + 1, nxt);
    const char* nA = cA; const char* nB = cB; nxtR = curR;
    if (has_next) unit_ptrs(g, nxt, tstepA, tstepB, nA, nB, nxtR);
    for (int t = 0; t < nt; t += 2) {
      const bool last = (t == nt - 2);
      const char* a1 = cA + (size_t)(t + 1) * kstep;
      const char* a2 = last ? nA : cA + (size_t)(t + 2) * kstep; const char* b2 = last ? nB : cB + (size_t)(t + 2) * kstep;
      const char* a3 = a2 + kstep; const char* b3 = b2 + kstep;
      PG8_LDB(B0, 0, 0); PG8_SCHED; PG8_LDA(At, 0, 0); PG8_STAGE(PG8_SA(1, 1), a1 + hstepA, voffA);
      PG8_WAIT_L(8); PG8_BAR; PG8_WAIT_L(0); PG8_MMA(0, 0, At, B0); PG8_BAR; PG8_SCHED;
      PG8_LDB(B1, 0, 1); PG8_STAGE(PG8_SB(0, 0), b2, voffB);
      PG8_BAR; PG8_WAIT_L(0); PG8_MMA(0, 1, At, B1); PG8_BAR;
      PG8_LDA(At, 0, 1); PG8_STAGE(PG8_SA(0, 0), a2, voffA);
      PG8_BAR; PG8_WAIT_L(0); PG8_MMA(1, 0, At, B0); PG8_BAR; PG8_SCHED;
      PG8_STAGE(PG8_SB(0, 1), b2 + hstepB, voffB);
      PG8_WAIT_V(6); PG8_BAR; PG8_MMA(1, 1, At, B1); PG8_BAR;
      PG8_LDB(B0, 1, 0); PG8_SCHED; PG8_LDA(At, 1, 0); PG8_STAGE(PG8_SA(0, 1), a2 + hstepA, voffA);
      PG8_WAIT_L(8); PG8_BAR; PG8_WAIT_L(0); PG8_MMA(0, 0, At, B0); PG8_BAR; PG8_SCHED;
      PG8_LDB(B1, 1, 1); PG8_STAGE(PG8_SB(1, 0), b3, voffB);
      PG8_BAR; PG8_WAIT_L(0); PG8_MMA(0, 1, At, B1); PG8_BAR;
      PG8_LDA(At, 1, 1); PG8_STAGE(PG8_SA(1, 0), a3, voffA);
      PG8_BAR; PG8_WAIT_L(0); PG8_MMA(1, 0, At, B0); PG8_BAR; PG8_SCHED;
      PG8_STAGE(PG8_SB(1, 1), b3 + hstepB, voffB);
      PG8_WAIT_V(6); PG8_BAR; PG8_MMA(1, 1, At, B1); PG8_BAR;
    }
    E(acc, curR, wr, wc, fr, fq);
    if (!has_next) break;
#pragma unroll
    for (int a = 0; a < 2; ++a)
#pragma unroll
      for (int b = 0; b < 2; ++b)
#pragma unroll
        for (int m = 0; m < 4; ++m)
#pragma unroll
          for (int n = 0; n < 2; ++n) acc[a][b][m][n] = (f32x4){0.f, 0.f, 0.f, 0.f};
    cur = nxt; curR = nxtR; cA = nA; cB = nB; ++ui;
  }
  PG8_WAIT_V(0);
  if (wr == 0) PG8_BAR;
  PG8_BAR;
#undef PG8_SA
#undef PG8_SB
#undef PG8_STAGE
#undef PG8_LDA
#undef PG8_LDB
#undef PG8_MMA
#undef PG8_WAIT_V
#undef PG8_WAIT_L
#undef PG8_BAR
#undef PG8_SCHED
}

DI void store8(bf16_t* dst, const f32x4& a, const f32x4& b) {
  u32x4 w; w.x = pk2(a[0], a[1]); w.y = pk2(a[2], a[3]); w.z = pk2(b[0], b[1]); w.w = pk2(b[2], b[3]);
  *(u32x4*)dst = w;
}
enum { EP_PLAIN = 0, EP_RELU2 = 1, EP_QKC = 2, EP_VT = 3, EP_ZT = 4 };
template <int MODE> struct Epi {
  static constexpr bool PERM = true;
  bf16_t* O; bf16_t* O2; bf16_t* O3; const float* ropec; const float* ropes; int ldc; int rowmap; int aux;
  DI void operator()(const f32x4 (&acc)[2][2][4][2], const Unit& u, int wr, int wc, int fr, int fq) const {
    if constexpr (MODE == EP_PLAIN || MODE == EP_RELU2) {
      int rowbase = u.pm * 256;
      if (rowmap == 1) rowbase = (u.pm / 16) * TPB + (u.pm % 16) * 256;
      else if (rowmap == 2) rowbase = u.pm * TPB + 4096;
      const int rmul = (rowmap == 3) ? 16 : 1;
      if (rowmap == 3) rowbase = (u.pm / 16) * TPB + (u.pm % 16);
      if (rowmap == 4) rowbase = (u.pm % aux) * 1024 + (u.pm / aux) * 256;
#pragma unroll
      for (int ai = 0; ai < 2; ++ai)
#pragma unroll
        for (int m = 0; m < 4; ++m) {
          const size_t row = (size_t)(rowbase + rmul * (ai * 128 + wr * 64 + m * 16 + fr));
#pragma unroll
          for (int bj = 0; bj < 2; ++bj) {
            const int col = u.pn * 256 + bj * 128 + wc * 32 + 8 * fq;
            f32x4 v0 = acc[ai][bj][m][0], v1 = acc[ai][bj][m][1];
            if constexpr (MODE == EP_RELU2) {
#pragma unroll
              for (int e = 0; e < 4; ++e) { float a = fmaxf(v0[e], 0.f), b = fmaxf(v1[e], 0.f); v0[e] = a * a; v1[e] = b * b; }
            }
            store8(O + row * ldc + col, v0, v1);
          }
        }
    } else if constexpr (MODE == EP_QKC) {
      const int pn = u.pn, b = u.pm / 17, pmr = u.pm % 17; const bool latent = pmr < 16;
#pragma unroll
      for (int ai = 0; ai < 2; ++ai)
#pragma unroll
        for (int m = 0; m < 4; ++m) {
          const int t = pmr * 256 + ai * 128 + wr * 64 + m * 16 + fr;
          const size_t row = (size_t)b * TPB + t;
#pragma unroll
          for (int bj = 0; bj < 2; ++bj) {
            const int col = pn * 256 + bj * 128 + wc * 32 + 8 * fq;
            f32x4 v0 = acc[ai][bj][m][0], v1 = acc[ai][bj][m][1];
            if (pn < 6) { store8(O + row * 1536 + col, v0, v1); }
            else {
              if (latent) {
                const int pos = (wc & 1) ? (t & 63) : (t >> 6);
                const float* cp = ropec + pos * 16 + 8 * (fq & 1); const float* sp = ropes + pos * 16 + 8 * (fq & 1);
                const f32x4 c0 = *(const f32x4*)cp, c1 = *(const f32x4*)(cp + 4), s0 = *(const f32x4*)sp, s1 = *(const f32x4*)(sp + 4);
                const float sgn = (fq < 2) ? -1.f : 1.f;
#pragma unroll
                for (int e = 0; e < 4; ++e) {
                  const float p0 = __shfl_xor(v0[e], 32), p1 = __shfl_xor(v1[e], 32);
                  v0[e] = v0[e] * c0[e] + sgn * p0 * s0[e];
                  v1[e] = v1[e] * c1[e] + sgn * p1 * s1[e];
                }
              }
              if (pn < 8) { store8(O2 + row * 512 + (col - 1536), v0, v1); }
              else {
                const int head = (pn - 8) * 2 + bj, comp = wc >> 1, d0 = (wc & 1) * 32 + 8 * fq;
                store8(O3 + ((size_t)((b * 4 + head) * 2 + comp) * TPB + t) * 64 + d0, v0, v1);
              }
            }
          }
        }
    } else if constexpr (MODE == EP_VT) {
      const int b = u.pn / 17, pnr = u.pn % 17;
#pragma unroll
      for (int ai = 0; ai < 2; ++ai)
#pragma unroll
        for (int m = 0; m < 4; ++m) {
          const int n = u.pm * 256 + ai * 128 + wr * 64 + m * 16 + fr; const int head = n >> 7, dv = n & 127;
#pragma unroll
          for (int bj = 0; bj < 2; ++bj) {
            const int t = pnr * 256 + bj * 128 + wc * 32 + 8 * fq;
            store8(O + ((size_t)((b * 4 + head) * 128 + dv)) * TPB + t, acc[ai][bj][m][0], acc[ai][bj][m][1]);
          }
        }
    } else {
      const int b = u.pn / 17, pnr = u.pn % 17;
#pragma unroll
      for (int ai = 0; ai < 2; ++ai)
#pragma unroll
        for (int m = 0; m < 4; ++m) {
          const int n = u.pm * 256 + ai * 128 + wr * 64 + m * 16 + fr; const int part = n >> 10, ch = n & 1023;
#pragma unroll
          for (int bj = 0; bj < 2; ++bj) {
            const int tt = pnr * 256 + bj * 128 + wc * 32 + 8 * fq;
            bf16_t* dst = (pnr < 16) ? O + ((size_t)(b * 1024 + ch)) * 8192 + part * 4096 + tt
                                     : O2 + ((size_t)(b * 1024 + ch)) * 512 + part * 256 + (tt - 4096);
            store8(dst, acc[ai][bj][m][0], acc[ai][bj][m][1]);
          }
        }
    }
  }
};

DI void tr_item(LAS float* tile, const float* src, bf16_t* dst, int K, int N, int tk, int tn) {
  const int tid = threadIdx.x;
#pragma unroll
  for (int i = 0; i < 2; ++i) {
    const int k = (tid >> 4) + 32 * i, n4 = (tid & 15) * 4;
    const f32x4 v = *(const f32x4*)(src + (size_t)(tk * 64 + k) * N + tn * 64 + n4);
    tile[k * 65 + n4 + 0] = v[0]; tile[k * 65 + n4 + 1] = v[1]; tile[k * 65 + n4 + 2] = v[2]; tile[k * 65 + n4 + 3] = v[3];
  }
  __syncthreads();
  const int n = tid >> 3, k0 = (tid & 7) * 8;
  float e[8];
#pragma unroll
  for (int i = 0; i < 8; ++i) e[i] = tile[(k0 + i) * 65 + n];
  u32x4 w; w.x = pk2(e[0], e[1]); w.y = pk2(e[2], e[3]); w.z = pk2(e[4], e[5]); w.w = pk2(e[6], e[7]);
  *(u32x4*)(dst + (size_t)(tn * 64 + n) * K + tk * 64 + k0) = w;
  __syncthreads();
}

DI void w12_item(LAS float* trig, const Params& p, int it) {
  const int tid = threadIdx.x;
  const int nh = it & 1, part = (it >> 1) & 1, co = (it >> 2) & 15, g = (it >> 6) & 7, j = it >> 9;
  if (tid < 128) { const float f = (float)tid * (1.0f / 128.0f); trig[tid] = __builtin_amdgcn_cosf(f); trig[128 + tid] = __builtin_amdgcn_sinf(f); }
  __syncthreads();
  const int n = nh * 512 + tid, c0 = co * 8;
  const float* W = p.w_out_f + (size_t)j * 1048576 + (size_t)(g * 128) * 1024 + n;
  float acc[8];
#pragma unroll
  for (int e = 0; e < 8; ++e) acc[e] = 0.f;
  for (int kc = 0; kc < 128; ++kc) {
    const float w = W[(size_t)kc * 1024];
#pragma unroll
    for (int e = 0; e < 8; ++e) acc[e] += w * trig[part * 128 + (((c0 + e) * kc) & 127)];
  }
  const float sc = 0.08838834764831845f;
  u32x4 o; o.x = pk2(acc[0] * sc, acc[1] * sc); o.y = pk2(acc[2] * sc, acc[3] * sc); o.z = pk2(acc[4] * sc, acc[5] * sc); o.w = pk2(acc[6] * sc, acc[7] * sc);
  bf16_t* dst = (bf16_t*)(p.ws + WS_W12) + (size_t)j * 2097152 + (size_t)(part * 1024 + n) * 1024 + g * 128 + c0;
  *(u32x4*)dst = o;
  __syncthreads();
}

DI void dn256_item(bf16_t* Dn, int it, float sgn, float scale) {
  const int idx0 = it * 512 + threadIdx.x, k = idx0 >> 6, col0 = (idx0 & 63) * 8, half = col0 >> 8, n0 = col0 & 255;
  float v[8];
#pragma unroll
  for (int e = 0; e < 8; ++e) {
    const int idx = (k * (n0 + e)) & 255; const float f = (float)idx * (1.0f / 256.0f);
    v[e] = (half ? sgn * __builtin_amdgcn_sinf(f) : __builtin_amdgcn_cosf(f)) * scale;
  }
  u32x4 o; o.x = pk2(v[0], v[1]); o.y = pk2(v[2], v[3]); o.z = pk2(v[4], v[5]); o.w = pk2(v[6], v[7]);
  *(u32x4*)(Dn + (size_t)k * 512 + col0) = o;
}
DI void rope_item(float* tab) {
#pragma unroll
  for (int i = 0; i < 2; ++i) {
    const int e = threadIdx.x + 512 * i, pos = e >> 4, fi = e & 15;
    const float inv = __builtin_amdgcn_exp2f(-(float)fi * (13.287712379549449f / 16.0f));
    const float ang = (float)pos * inv; float rev = ang * 0.15915494309189535f; rev = rev - floorf(rev);
    tab[e] = __builtin_amdgcn_cosf(rev); tab[1024 + e] = __builtin_amdgcn_sinf(rev);
  }
}
DI void modp_item(LAS float* sm, const Params& p, int it) {
  const int tid = threadIdx.x, layer = it / 96, rem = it % 96, cb = rem / 16, kc = rem % 16;
  LAS float* scv = sm;
  LAS float* red = sm + 320;
  if (tid < 320) { const int cond = tid >> 6, kk = tid & 63, k = kc * 64 + kk; const float v = cond < 4 ? p.c[cond * 1024 + k] : p.c_ctx[k];
    scv[tid] = v / (1.0f + __builtin_amdgcn_exp2f(-v * 1.4426950408889634f)); }
  __syncthreads();
  const int c4 = tid & 255, kh = tid >> 8;
  f32x4 acc[5];
#pragma unroll
  for (int cnd = 0; cnd < 5; ++cnd) acc[cnd] = (f32x4){0.f, 0.f, 0.f, 0.f};
  const float* wp = p.ada_w + ((size_t)layer * 1024 + kc * 64 + kh * 32) * 6144 + cb * 1024 + c4 * 4;
  for (int kk = 0; kk < 32; ++kk) {
    const f32x4 w = *(const f32x4*)(wp + (size_t)kk * 6144);
#pragma unroll
    for (int cnd = 0; cnd < 5; ++cnd) acc[cnd] += w * scv[cnd * 64 + kh * 32 + kk];
  }
  if (kh == 1) {
#pragma unroll
    for (int cnd = 0; cnd < 5; ++cnd) *(LAS f32x4*)(red + (cnd * 256 + c4) * 4) = acc[cnd];
  }
  __syncthreads();
  if (kh == 0) {
    float* mp = (float*)(p.ws + WS_MODP);
#pragma unroll
    for (int cnd = 0; cnd < 5; ++cnd) {
      const f32x4 o = acc[cnd] + *(const LAS f32x4*)(red + (cnd * 256 + c4) * 4);
      *(f32x4*)(mp + ((size_t)((kc * 4 + layer) * 5 + cnd)) * 6144 + cb * 1024 + c4 * 4) = o;
    }
  }
  __syncthreads();
}

DI void phase0(LAS unsigned char* lds, const Params& p) {
  LAS float* smf = (LAS float*)lds;
  constexpr int N_TR = 10240, N_W12 = 1024, N_DN = 32, N_D256 = 32, N_ROPE = 1, N_MODP = 384;
  constexpr int TOT = N_TR + N_W12 + N_DN + N_D256 + N_ROPE + N_MODP;
  for (int it = blockIdx.x; it < TOT; it += gridDim.x) {
    int i = it;
    if (i < N_MODP) { modp_item(smf, p, i); continue; }
    i -= N_MODP;
    if (i < N_W12) { w12_item(smf, p, i); continue; }
    i -= N_W12;
    if (i < N_TR) {
      if (i < 1536) { const int j = i / 768, rem = i % 768; tr_item(smf, p.w_in + (size_t)j * 3145728, (bf16_t*)(p.ws + WS_WIN) + (size_t)j * 3145728, 1024, 3072, rem / 48, rem % 48); }
      else if (i < 5632) { const int q = i - 1536, l = q / 1024, rem = q % 1024; tr_item(smf, p.w1 + (size_t)l * 4194304, (bf16_t*)(p.ws + WS_W1) + (size_t)l * 4194304, 1024, 4096, rem / 64, rem % 64); }
      else if (i < 9728) { const int q = i - 5632, l = q / 1024, rem = q % 1024; tr_item(smf, p.w2 + (size_t)l * 4194304, (bf16_t*)(p.ws + WS_W2) + (size_t)l * 4194304, 4096, 1024, rem / 16, rem % 16); }
      else { const int q = i - 9728, j = q / 256, rem = q % 256; tr_item(smf, p.w_out_mix + (size_t)j * 1048576, (bf16_t*)(p.ws + WS_WOM) + (size_t)j * 1048576, 1024, 1024, rem / 16, rem % 16); }
      continue;
    }
    i -= N_TR;
    if (i < N_DN) { dn256_item((bf16_t*)(p.ws + WS_DN2), i, 1.0f, 1.0f / 64.0f); continue; }
    i -= N_DN;
    if (i < N_D256) { dn256_item((bf16_t*)(p.ws + WS_DN256), i, -1.0f, 1.0f / 16.0f); continue; }
    rope_item((float*)(p.ws + WS_ROPE));
  }
}

DI void phase0b(const Params& p) {
  const float* mp = (const float*)(p.ws + WS_MODP); float* mod = (float*)(p.ws + WS_MOD);
  for (int i = blockIdx.x * 512 + threadIdx.x; i < 30720; i += gridDim.x * 512) {
    const int e = i * 4, layer = e / 30720, col = e % 6144;
    f32x4 a = *(const f32x4*)(p.ada_b + layer * 6144 + col);
#pragma unroll
    for (int kc = 0; kc < 16; ++kc) a += *(const f32x4*)(mp + (size_t)kc * 122880 + e);
    *(f32x4*)(mod + e) = a;
  }
}

DI void ln_pass(const Params& p, bool first, const float* gate, const float* lng, const float* lnb, const float* nsh, const float* nsc, bool last, bool lat_only, int nks) {
  int tid = threadIdx.x; asm volatile("" : "+v"(tid));
  const int wave = tid >> 6, lane = tid & 63;
  float* H = (float*)(p.ws + WS_H); const bf16_t* Y = (const bf16_t*)(p.ws + WS_Y); bf16_t* U = (bf16_t*)(p.ws + WS_U);
  const int npairs = (lat_only ? 16384 : NROW) / 2;
  for (int pi = blockIdx.x * 8 + wave; pi < npairs; pi += gridDim.x * 8) {
    const int rv = pi * 2;
    int b, t;
    if (lat_only) { b = rv >> 12; t = rv & 4095; } else { b = rv / TPB; t = rv % TPB; }
    const size_t r = (size_t)b * TPB + t; const int cond = t < 4096 ? b : 4;
    float v[2][16];
    if (first) {
      const float* src = t < 4096 ? p.x + ((size_t)(b * 4096 + t)) * 1024 : p.ctx + ((size_t)(b * 256 + t - 4096)) * 1024;
#pragma unroll
      for (int z = 0; z < 2; ++z)
#pragma unroll
        for (int q = 0; q < 4; ++q) { const f32x4 a = *(const f32x4*)(src + z * 1024 + q * 256 + lane * 4); v[z][4 * q] = a[0]; v[z][4 * q + 1] = a[1]; v[z][4 * q + 2] = a[2]; v[z][4 * q + 3] = a[3]; }
    } else {
      const float* hr = H + r * 1024; const bf16_t* yr = Y + r * 1024; const float* gr = gate + cond * 6144;
      f32x4 ha[2][4]; f32x4 yv[2][4];
#pragma unroll
      for (int z = 0; z < 2; ++z)
#pragma unroll
        for (int q = 0; q < 4; ++q) { const int c = z * 1024 + q * 256 + lane * 4; ha[z][q] = *(const f32x4*)(hr + c); }
      if (nks > 0 && t >= 4096) {
        const bf16_t* pr = (const bf16_t*)p.out + ((size_t)(b * 256 + t - 4096)) * 1024;
#pragma unroll
        for (int z = 0; z < 2; ++z)
#pragma unroll
          for (int q = 0; q < 4; ++q) yv[z][q] = (f32x4){0.f, 0.f, 0.f, 0.f};
        for (int ks = 0; ks < nks; ++ks) {
#pragma unroll
          for (int z = 0; z < 2; ++z)
#pragma unroll
            for (int q = 0; q < 4; ++q) { const u32x2 w = *(const u32x2*)(pr + (size_t)ks * 1048576 + z * 1024 + q * 256 + lane * 4);
              yv[z][q][0] += bflo(w.x); yv[z][q][1] += bfhi(w.x); yv[z][q][2] += bflo(w.y); yv[z][q][3] += bfhi(w.y); }
        }
      } else {
#pragma unroll
        for (int z = 0; z < 2; ++z)
#pragma unroll
          for (int q = 0; q < 4; ++q) { const u32x2 w = *(const u32x2*)(yr + z * 1024 + q * 256 + lane * 4); yv[z][q] = (f32x4){bflo(w.x), bfhi(w.x), bflo(w.y), bfhi(w.y)}; }
      }
      float s[2] = {0.f, 0.f};
#pragma unroll
      for (int q = 0; q < 4; ++q) {
        const f32x4 g = *(const f32x4*)(gr + q * 256 + lane * 4);
#pragma unroll
        for (int z = 0; z < 2; ++z) {
#pragma unroll
          for (int e = 0; e < 4; ++e) v[z][4 * q + e] = ALPHA * ha[z][q][e] + g[e] * yv[z][q][e];
          s[z] += v[z][4 * q] + v[z][4 * q + 1] + v[z][4 * q + 2] + v[z][4 * q + 3];
        }
      }
      float mu[2], rstd[2];
#pragma unroll
      for (int z = 0; z < 2; ++z) mu[z] = wave_sum(s[z]) * (1.0f / 1024.0f);
#pragma unroll
      for (int z = 0; z < 2; ++z) { float ss = 0.f;
#pragma unroll
        for (int e = 0; e < 16; ++e) { const float d = v[z][e] - mu[z]; ss += d * d; }
        s[z] = ss; }
#pragma unroll
      for (int z = 0; z < 2; ++z) rstd[z] = __builtin_amdgcn_rsqf(wave_sum(s[z]) * (1.0f / 1024.0f) + 1e-6f);
#pragma unroll
      for (int q = 0; q < 4; ++q) {
        const int c = q * 256 + lane * 4;
        const f32x4 g = *(const f32x4*)(lng + c), bb = *(const f32x4*)(lnb + c);
#pragma unroll
        for (int z = 0; z < 2; ++z)
#pragma unroll
          for (int e = 0; e < 4; ++e) v[z][4 * q + e] = (v[z][4 * q + e] - mu[z]) * rstd[z] * g[e] + bb[e];
      }
    }
    float* dst = last ? p.out + ((size_t)(b * 4096 + t)) * 1024 : H + r * 1024;
#pragma unroll
    for (int z = 0; z < 2; ++z)
#pragma unroll
      for (int q = 0; q < 4; ++q) *(f32x4*)(dst + z * 1024 + q * 256 + lane * 4) = (f32x4){v[z][4 * q], v[z][4 * q + 1], v[z][4 * q + 2], v[z][4 * q + 3]};
    if (!last) {
      float s[2], mu[2], rstd[2];
#pragma unroll
      for (int z = 0; z < 2; ++z) { float a = 0.f;
#pragma unroll
        for (int e = 0; e < 16; ++e) a += v[z][e];
        s[z] = a; }
#pragma unroll
      for (int z = 0; z < 2; ++z) mu[z] = wave_sum(s[z]) * (1.0f / 1024.0f);
#pragma unroll
      for (int z = 0; z < 2; ++z) { float ss = 0.f;
#pragma unroll
        for (int e = 0; e < 16; ++e) { const float d = v[z][e] - mu[z]; ss += d * d; }
        s[z] = ss; }
#pragma unroll
      for (int z = 0; z < 2; ++z) rstd[z] = __builtin_amdgcn_rsqf(wave_sum(s[z]) * (1.0f / 1024.0f) + 1e-6f);
      const float* shr = nsh + cond * 6144; const float* scr = nsc + cond * 6144;
#pragma unroll
      for (int q = 0; q < 4; ++q) {
        const int c = q * 256 + lane * 4;
        const f32x4 sh = *(const f32x4*)(shr + c), sc = *(const f32x4*)(scr + c);
#pragma unroll
        for (int z = 0; z < 2; ++z) {
          float o[4];
#pragma unroll
          for (int e = 0; e < 4; ++e) o[e] = (v[z][4 * q + e] - mu[z]) * rstd[z] * (1.0f + sc[e]) + sh[e];
          u32x2 w; w.x = pk2(o[0], o[1]); w.y = pk2(o[2], o[3]);
          *(u32x2*)(U + (r + z) * 1024 + c) = w;
        }
      }
    }
  }
}


DI void dft4(float& r0, float& i0, float& r1, float& i1, float& r2, float& i2, float& r3, float& i3) {
  const float t0r = r0 + r2, t0i = i0 + i2, t1r = r0 - r2, t1i = i0 - i2, t2r = r1 + r3, t2i = i1 + i3, t3r = r1 - r3, t3i = i1 - i3;
  r0 = t0r + t2r; i0 = t0i + t2i; r2 = t0r - t2r; i2 = t0i - t2i;
  r1 = t1r + t3i; i1 = t1i - t3r; r3 = t1r - t3i; i3 = t1i + t3r;
}
DI void fft16_pass(const Params& p) {
  int tid = threadIdx.x; asm volatile("" : "+v"(tid));
  const bf16_t* Zt = (const bf16_t*)(p.ws + WS_ZT); bf16_t* Wt = (bf16_t*)(p.ws + WS_WT);
  const int sub = tid >> 7, np = tid & 127, n1 = np * 2;
  for (int it = blockIdx.x; it < 1024; it += gridDim.x) {
    const int bc = it * 4 + sub, b = bc >> 10, ch = bc & 1023;
    const bf16_t* zr = Zt + (size_t)bc * 8192 + n1;
    unsigned ga[16], gb[16];
#pragma unroll
    for (int n2 = 0; n2 < 16; ++n2) { ga[n2] = *(const unsigned*)(zr + 256 * n2); gb[n2] = *(const unsigned*)(zr + 4096 + 256 * n2); }
    float outr[2][16], outi[2][16];
#pragma unroll
    for (int z = 0; z < 2; ++z) {
      float xr[16], xi[16];
#pragma unroll
      for (int n2 = 0; n2 < 16; ++n2) { xr[n2] = z ? bfhi(ga[n2]) : bflo(ga[n2]); xi[n2] = -(z ? bfhi(gb[n2]) : bflo(gb[n2])); }
#pragma unroll
      for (int bb = 0; bb < 4; ++bb) dft4(xr[bb], xi[bb], xr[4 + bb], xi[4 + bb], xr[8 + bb], xi[8 + bb], xr[12 + bb], xi[12 + bb]);
#pragma unroll
      for (int c = 1; c < 4; ++c)
#pragma unroll
        for (int bb = 1; bb < 4; ++bb) {
          const int m = bb * c;
          const float cw = (m == 1) ? 0.9238795325112867f : (m == 2) ? 0.7071067811865476f : (m == 3) ? 0.3826834323650898f : (m == 4) ? 0.f : (m == 6) ? -0.7071067811865476f : -0.9238795325112867f;
          const float sw = (m == 1) ? 0.3826834323650898f : (m == 2) ? 0.7071067811865476f : (m == 3) ? 0.9238795325112867f : (m == 4) ? 1.f : (m == 6) ? 0.7071067811865476f : -0.3826834323650898f;
          const float a = xr[4 * c + bb], bq = xi[4 * c + bb];
          xr[4 * c + bb] = a * cw + bq * sw; xi[4 * c + bb] = bq * cw - a * sw;
        }
#pragma unroll
      for (int c = 0; c < 4; ++c) dft4(xr[4 * c], xi[4 * c], xr[4 * c + 1], xi[4 * c + 1], xr[4 * c + 2], xi[4 * c + 2], xr[4 * c + 3], xi[4 * c + 3]);
#pragma unroll
      for (int c = 0; c < 4; ++c)
#pragma unroll
        for (int d = 0; d < 4; ++d) {
          const int k2 = c + 4 * d;
          const float f = (float)(k2 * (n1 + z)) * (1.0f / 4096.0f);
          const float cw = __builtin_amdgcn_cosf(f), sw = __builtin_amdgcn_sinf(f);
          const float a = xr[4 * c + d], bq = xi[4 * c + d];
          outr[z][k2] = a * cw + bq * sw; outi[z][k2] = bq * cw - a * sw;
        }
    }
    bf16_t* wr0 = Wt + ((size_t)(b * 16) * 1024 + ch) * 512 + n1;
#pragma unroll
    for (int k2 = 0; k2 < 16; ++k2) {
      bf16_t* wp = wr0 + (size_t)k2 * (1024 * 512);
      *(unsigned*)wp = pk2(outr[0][k2], outr[1][k2]);
      *(unsigned*)(wp + 256) = pk2(outi[0][k2], outi[1][k2]);
    }
  }
}

#define MFMA32(a, b, c) __builtin_amdgcn_mfma_f32_32x32x16_bf16((a), (b), (c), 0, 0, 0)
constexpr int ATT_BUF = 35840, ATT_KC = 9216, ATT_V = 18432;

DI void attn_item(LAS unsigned char* lds, const Params& p, int b, int head, int t0, int kt0, int kt1, float lam, float oscale, const float* subg) {
  int tid = threadIdx.x; asm volatile("" : "+v"(tid));
  const int wid = tid >> 6, lane = tid & 63, r = lane & 31, h = lane >> 5, comp = wid >> 2, wq = wid & 3;
  const bf16_t* Qb = (const bf16_t*)(p.ws + WS_QB); const bf16_t* Kb = (const bf16_t*)(p.ws + WS_KB); const bf16_t* Vt = (const bf16_t*)(p.ws + WS_VT);
  bf16_t* mix = (bf16_t*)(p.ws + WS_MIX);
  const size_t qrow = (size_t)b * TPB + t0 + wq * 32 + r;
  bf16x8 qf[4];
  { const bf16_t* qp = Qb + qrow * 512 + head * 128 + comp * 64 + 8 * h;
#pragma unroll
    for (int s = 0; s < 4; ++s) qf[s] = *(const bf16x8*)(qp + 16 * s); }
  f32x16 o[4];
#pragma unroll
  for (int k = 0; k < 4; ++k)
#pragma unroll
    for (int i = 0; i < 16; ++i) o[k][i] = 0.f;
  float mrun = -1e30f, lrun = 0.f;
  const float sc = 0.125f * 1.4426950408889634f;
  const char* kg = (const char*)(Kb + ((size_t)((b * 4 + head) * 2) * TPB) * 64) + (size_t)tid * 16;
  const char* vg = (const char*)(Vt + ((size_t)((b * 4 + head) * 128 + (tid >> 3))) * TPB) + (tid & 7) * 16;
  const unsigned kl = (unsigned)((tid >> 3) * 144 + (tid & 7) * 16);
  const unsigned vl = (unsigned)(ATT_V + (tid >> 3) * 136 + (tid & 7) * 16);
  u32x4 kr[2], vr[2];
#define ATT_LOAD(kt) do { _Pragma("unroll") for (int i = 0; i < 2; ++i) { \
    kr[i] = *(const u32x4*)(kg + (size_t)i * (TPB * 128) + (size_t)(kt) * 8192); \
    vr[i] = *(const u32x4*)(vg + (size_t)i * (64 * TPB * 2) + (size_t)(kt) * 128); } } while (0)
#define ATT_STORE(buf) do { _Pragma("unroll") for (int i = 0; i < 2; ++i) { \
    *(LAS u32x4*)(lds + (buf) * ATT_BUF + i * ATT_KC + kl) = kr[i]; \
    *(LAS u32x2*)(lds + (buf) * ATT_BUF + i * (64 * 136) + vl) = (u32x2){vr[i].x, vr[i].y}; \
    *(LAS u32x2*)(lds + (buf) * ATT_BUF + i * (64 * 136) + vl + 8) = (u32x2){vr[i].z, vr[i].w}; } } while (0)
  ATT_LOAD(kt0);
  ATT_STORE(0);
  __syncthreads();
  int buf = 0;
  for (int kt = kt0; kt < kt1; ++kt) {
    const bool more = (kt + 1 < kt1);
    if (more) ATT_LOAD(kt + 1);
    const LAS unsigned char* ks = lds + buf * ATT_BUF + comp * ATT_KC + r * 144 + h * 16;
    const LAS unsigned char* vs = lds + buf * ATT_BUF + ATT_V + r * 136 + h * 8;
    f32x16 x[2];
#pragma unroll
    for (int kb = 0; kb < 2; ++kb) {
#pragma unroll
      for (int i = 0; i < 16; ++i) x[kb][i] = 0.f;
#pragma unroll
      for (int s = 0; s < 4; ++s) { const bf16x8 a = *(const LAS bf16x8*)(ks + kb * 4608 + s * 32); x[kb] = MFMA32(a, qf[s], x[kb]); }
    }
    float mx = x[0][0];
#pragma unroll
    for (int kb = 0; kb < 2; ++kb)
#pragma unroll
      for (int i = 0; i < 16; ++i) mx = fmaxf(mx, x[kb][i]);
    mx = fmaxf(mx, __shfl_xor(mx, 32));
    const float mnew = fmaxf(mrun, mx * sc);
    const float alpha = __builtin_amdgcn_exp2f(mrun - mnew);
    mrun = mnew;
    float ps = 0.f;
#pragma unroll
    for (int kb = 0; kb < 2; ++kb)
#pragma unroll
      for (int i = 0; i < 16; ++i) { const float e = __builtin_amdgcn_exp2f(x[kb][i] * sc - mnew); x[kb][i] = e; ps += e; }
    lrun = lrun * alpha + ps;
#pragma unroll
    for (int k = 0; k < 4; ++k)
#pragma unroll
      for (int i = 0; i < 16; ++i) o[k][i] *= alpha;
#pragma unroll
    for (int kb = 0; kb < 2; ++kb)
#pragma unroll
      for (int s2 = 0; s2 < 2; ++s2) {
        u32x4 pw; pw.x = pk2(x[kb][8 * s2], x[kb][8 * s2 + 1]); pw.y = pk2(x[kb][8 * s2 + 2], x[kb][8 * s2 + 3]);
        pw.z = pk2(x[kb][8 * s2 + 4], x[kb][8 * s2 + 5]); pw.w = pk2(x[kb][8 * s2 + 6], x[kb][8 * s2 + 7]);
        const bf16x8 pb = __builtin_bit_cast(bf16x8, pw);
#pragma unroll
        for (int blk = 0; blk < 4; ++blk) {
          const s16x4 lo = *(const LAS s16x4*)(vs + blk * 4352 + kb * 64 + s2 * 32);
          const s16x4 hi = *(const LAS s16x4*)(vs + blk * 4352 + kb * 64 + s2 * 32 + 16);
          const bf16x8 a = __builtin_shufflevector(lo, hi, 0, 1, 2, 3, 4, 5, 6, 7);
          o[blk] = MFMA32(a, pb, o[blk]);
        }
      }
    if (more) ATT_STORE(buf ^ 1);
    __syncthreads();
    buf ^= 1;
  }
#undef ATT_LOAD
#undef ATT_STORE
  const float ltot = lrun + __shfl_xor(lrun, 32);
  const float inv = 1.0f / ltot;
  LAS float* cmb = (LAS float*)lds;
  if (comp == 1) {
#pragma unroll
    for (int k = 0; k < 4; ++k)
#pragma unroll
      for (int i = 0; i < 16; ++i) cmb[(wq * 64 + k * 16 + i) * 64 + lane] = o[k][i] * inv;
  }
  __syncthreads();
  if (comp == 0) {
    float ss = 0.f;
#pragma unroll
    for (int k = 0; k < 4; ++k)
#pragma unroll
      for (int i = 0; i < 16; ++i) { const float d = o[k][i] * inv - lam * cmb[(wq * 64 + k * 16 + i) * 64 + lane]; o[k][i] = d; ss += d * d; }
    ss += __shfl_xor(ss, 32);
    const float rn = __builtin_amdgcn_rsqf(ss * (1.0f / 128.0f) + 1e-5f) * oscale;
    bf16_t* dst = mix + qrow * 1024 + 512 + head * 128;
#pragma unroll
    for (int k = 0; k < 4; ++k)
#pragma unroll
      for (int g4 = 0; g4 < 4; ++g4) {
        const int dv = 32 * k + 8 * g4 + 4 * h;
        const f32x4 gg = *(const f32x4*)(subg + dv);
        u32x2 w; w.x = pk2(o[k][4 * g4] * rn * gg[0], o[k][4 * g4 + 1] * rn * gg[1]); w.y = pk2(o[k][4 * g4 + 2] * rn * gg[2], o[k][4 * g4 + 3] * rn * gg[3]);
        *(u32x2*)(dst + dv) = w;
      }
  }
  __syncthreads();
}

DI void conv_item(const Params& p, int ci, const float* cw) {
  int tid = threadIdx.x; asm volatile("" : "+v"(tid));
  const int cg8 = tid & 63, rr = tid >> 6, c0 = cg8 * 8;
  const bf16_t* P = (const bf16_t*)(p.ws + WS_P); bf16_t* mix = (bf16_t*)(p.ws + WS_MIX);
  float w0[8], w1[8], w2[8];
#pragma unroll
  for (int e = 0; e < 8; ++e) { w0[e] = cw[c0 + e]; w1[e] = cw[512 + c0 + e]; w2[e] = cw[1024 + c0 + e]; }
#pragma unroll 1
  for (int q = 0; q < 4; ++q) {
    const int r = ci * 32 + rr + 8 * q, t = r % TPB;
    const bf16_t* pr = P + (size_t)r * 1536 + c0;
    const u32x4 gb = *(const u32x4*)pr;
    const u32x4 gc1 = *(const u32x4*)(pr + 512), v1 = *(const u32x4*)(pr + 1024);
    u32x4 gc0 = (u32x4){0, 0, 0, 0}, v0 = gc0, gc2 = gc0, v2 = gc0;
    if (t != 0 && t != 4096) { gc0 = *(const u32x4*)(pr - 1536 + 512); v0 = *(const u32x4*)(pr - 1536 + 1024); }
    if (t != 4095 && t != 4351) { gc2 = *(const u32x4*)(pr + 1536 + 512); v2 = *(const u32x4*)(pr + 1536 + 1024); }
    float o[8];
#pragma unroll
    for (int e2 = 0; e2 < 4; ++e2) {
      const float a0 = bflo(gc0[e2]) * bflo(v0[e2]), a1 = bflo(gc1[e2]) * bflo(v1[e2]), a2 = bflo(gc2[e2]) * bflo(v2[e2]);
      const float b0 = bfhi(gc0[e2]) * bfhi(v0[e2]), b1 = bfhi(gc1[e2]) * bfhi(v1[e2]), b2 = bfhi(gc2[e2]) * bfhi(v2[e2]);
      o[2 * e2] = bflo(gb[e2]) * (w0[2 * e2] * a0 + w1[2 * e2] * a1 + w2[2 * e2] * a2);
      o[2 * e2 + 1] = bfhi(gb[e2]) * (w0[2 * e2 + 1] * b0 + w1[2 * e2 + 1] * b1 + w2[2 * e2 + 1] * b2);
    }
    u32x4 w; w.x = pk2(o[0], o[1]); w.y = pk2(o[2], o[3]); w.z = pk2(o[4], o[5]); w.w = pk2(o[6], o[7]);
    *(u32x4*)(mix + (size_t)r * 1024 + c0) = w;
  }
}

DI void attn_phase(LAS unsigned char* lds, const Params& p, int layer) {
  int tid0 = threadIdx.x; asm volatile("" : "+v"(tid0));
  const int j = layer >> 1, lane = tid0 & 63;
  const float lam_init = (layer == 0) ? 0.2f : 0.47071301834382377f;
  const float* lq = p.lam_qk + j * 256;
  const float sa = wave_sum(lq[lane] * lq[64 + lane]), sb = wave_sum(lq[128 + lane] * lq[192 + lane]);
  const float lam = __builtin_amdgcn_exp2f(sa * 1.4426950408889634f) - __builtin_amdgcn_exp2f(sb * 1.4426950408889634f) + lam_init;
  const float oscale = 1.0f - lam_init;
  const float* subg = p.subln_g + j * 128;
  const float* cw = p.conv_w + j * 1536;
  const int natt = 512 + (layer == 0 ? 32 : 0), total = natt + 544;
  for (int it = blockIdx.x; it < total; it += gridDim.x) {
    if (it < 512) {
      const int round = it >> 8, c = it & 255, pair = round * 8 + (c & 7), qblk = c >> 3;
      attn_item(lds, p, pair >> 2, pair & 3, qblk * 128, 0, 68, lam, oscale, subg);
    } else if (it < natt) {
      const int c = it - 512;
      attn_item(lds, p, c >> 3, (c >> 1) & 3, 4096 + (c & 1) * 128, 64, 68, lam, oscale, subg);
    } else conv_item(p, it - natt, cw);
  }
}

__global__ void __launch_bounds__(512, 2) fwd_megakernel(Params p) {
  extern __shared__ __attribute__((aligned(16))) unsigned char shm[];
  LAS unsigned char* lds = (LAS unsigned char*)shm;
  cg::grid_group grid = cg::this_grid();
  unsigned char* ws = p.ws;
  const float* mod = (const float*)(ws + WS_MOD);
  bf16_t* U = (bf16_t*)(ws + WS_U); bf16_t* Y = (bf16_t*)(ws + WS_Y);

  unsigned* bar = (unsigned*)(ws + WS_BAR);
  volatile LAS unsigned* xst = (volatile LAS unsigned*)(lds + 131072);
  if (blockIdx.x == 0) for (int i = threadIdx.x; i < XCD_BAR_WORDS; i += 512) __hip_atomic_store(&bar[i], 0u, __ATOMIC_RELAXED, __HIP_MEMORY_SCOPE_AGENT);
  if (threadIdx.x == 0) { xst[0] = 0u; xst[1] = 0u; }
  __syncthreads();
  for (int rep = 0; rep < REP_P0; ++rep) { phase0(lds, p); __syncthreads(); }
  grid.sync();
  const XcdBarrier xb = xcd_barrier_post(bar, xst);
#define GSYNC() xcd_barrier(xb)
  phase0b(p);
  GSYNC();
  ln_pass(p, true, nullptr, nullptr, nullptr, mod + 0, mod + 1024, false, false, 0);
  GSYNC();

  bf16_t* PART = (bf16_t*)p.out;
  for (int layer = 0; layer < 4; ++layer) {
    const int j = layer >> 1;
    const float* lmod = mod + (size_t)layer * 30720;
    const bool ctx_alive = layer < 2;
    int nks_mid = 0;
    if ((layer & 1) == 0) {
      { Gemm g{U, (const bf16_t*)(ws + WS_WIN) + (size_t)j * 3145728, NROW, 2560, 1024, 0, 1, 0, 1024, 1024};
        Epi<EP_QKC> e{(bf16_t*)(ws + WS_P), (bf16_t*)(ws + WS_QB), (bf16_t*)(ws + WS_KB), (const float*)(ws + WS_ROPE), (const float*)(ws + WS_ROPE) + 1024, 0, 0, 0};
        for (int rep = 0; rep < REP_GEMM; ++rep) gemm_phase(lds, g, e); }
      { Gemm g{(const bf16_t*)(ws + WS_WIN) + (size_t)j * 3145728 + (size_t)2560 * 1024, U, 512, NROW, 1024, 0, 1, 0, 1024, 1024};
        Epi<EP_VT> e{(bf16_t*)(ws + WS_VT), nullptr, nullptr, nullptr, nullptr, 0, 0, 0};
        for (int rep = 0; rep < REP_GEMM; ++rep) gemm_phase(lds, g, e); }
      GSYNC();
      for (int rep = 0; rep < REP_ATT; ++rep) attn_phase(lds, p, layer);
      GSYNC();
      { Gemm g{(const bf16_t*)(ws + WS_MIX), (const bf16_t*)(ws + WS_WOM) + (size_t)j * 1048576, 16384, 1024, 1024, 1, 1, 0, 1024, 1024};
        Epi<EP_PLAIN> e{Y, nullptr, nullptr, nullptr, nullptr, 1024, 0, 0};
        for (int rep = 0; rep < REP_GEMM; ++rep) gemm_phase(lds, g, e); }
      if (ctx_alive) {
        Gemm g{(const bf16_t*)(ws + WS_MIX), (const bf16_t*)(ws + WS_WOM) + (size_t)j * 1048576, 4096, 1024, 256, 4, 4, 0, 1024, 1024};
        Epi<EP_PLAIN> e{PART, nullptr, nullptr, nullptr, nullptr, 1024, 4, 4};
        for (int rep = 0; rep < REP_GEMM; ++rep) gemm_phase(lds, g, e);
        nks_mid = 4;
      }
      GSYNC();
    } else {
      { Gemm g{(const bf16_t*)(ws + WS_W12) + (size_t)j * 2097152, U, 2048, ctx_alive ? NROW : 16384, 1024, ctx_alive ? 0 : 2, 1, 0, 1024, 1024};
        Epi<EP_ZT> e{(bf16_t*)(ws + WS_ZT), (bf16_t*)(ws + WS_ZTC), nullptr, nullptr, nullptr, 0, 0, 0};
        for (int rep = 0; rep < REP_GEMM; ++rep) gemm_phase(lds, g, e); }
      GSYNC();
      fft16_pass(p);
      GSYNC();
      { Gemm g{(const bf16_t*)(ws + WS_DN2), (const bf16_t*)(ws + WS_WT), 16384, 1024, 512, 3, 1, (size_t)1024 * 512 * 2, 512, 512};
        Epi<EP_PLAIN> e{Y, nullptr, nullptr, nullptr, nullptr, 1024, 3, 0};
        for (int rep = 0; rep < REP_GEMM; ++rep) gemm_phase(lds, g, e); }
      if (ctx_alive) {
        Gemm g{(const bf16_t*)(ws + WS_DN256), (const bf16_t*)(ws + WS_ZTC), 1024, 1024, 512, 3, 1, (size_t)1024 * 512 * 2, 512, 512};
        Epi<EP_PLAIN> e{Y, nullptr, nullptr, nullptr, nullptr, 1024, 2, 0};
        for (int rep = 0; rep < REP_GEMM; ++rep) gemm_phase(lds, g, e);
      }
      GSYNC();
    }
    ln_pass(p, false, lmod + 2048, p.ln_g + (size_t)(layer * 2) * 1024, p.ln_b + (size_t)(layer * 2) * 1024, lmod + 3072, lmod + 4096, false, !ctx_alive, nks_mid);
    GSYNC();
    { Gemm g{U, (const bf16_t*)(ws + WS_W1) + (size_t)layer * 4194304, ctx_alive ? NROW : 16384, 4096, 1024, ctx_alive ? 0 : 1, 1, 0, 1024, 1024};
      Epi<EP_RELU2> e{(bf16_t*)(ws + WS_HID), nullptr, nullptr, nullptr, nullptr, 4096, 0, 0};
      for (int rep = 0; rep < REP_GEMM; ++rep) gemm_phase(lds, g, e); }
    GSYNC();
    { Gemm g{(const bf16_t*)(ws + WS_HID), (const bf16_t*)(ws + WS_W2) + (size_t)layer * 4194304, 16384, 1024, 4096, 1, 1, 0, 4096, 4096};
      Epi<EP_PLAIN> e{Y, nullptr, nullptr, nullptr, nullptr, 1024, 0, 0};
      for (int rep = 0; rep < REP_GEMM; ++rep) gemm_phase(lds, g, e); }
    if (ctx_alive) {
      Gemm g{(const bf16_t*)(ws + WS_HID), (const bf16_t*)(ws + WS_W2) + (size_t)layer * 4194304, 16384, 1024, 256, 4, 16, 0, 4096, 4096};
      Epi<EP_PLAIN> e{PART, nullptr, nullptr, nullptr, nullptr, 1024, 4, 16};
      for (int rep = 0; rep < REP_GEMM; ++rep) gemm_phase(lds, g, e);
    }
    GSYNC();
    const bool lat_only_end = layer >= 2;
    const float* nmod = mod + (size_t)(layer + 1) * 30720;
    ln_pass(p, false, lmod + 5120, p.ln_g + (size_t)(layer * 2 + 1) * 1024, p.ln_b + (size_t)(layer * 2 + 1) * 1024, nmod + 0, nmod + 1024, layer == 3, lat_only_end, ctx_alive ? 16 : 0);
    if (layer < 3) { for (int rep = 0; rep < 1 + 10 * (REP_SYNC - 1); ++rep) GSYNC(); }
  }
}

extern "C" void kernel_launch(void* const* d_in, const int* in_sizes, int n_in, void* d_out, int out_size, void* d_ws, size_t ws_size, hipStream_t stream) {
  constexpr size_t kDynLds = 131072 + 256;
  static int grid_blocks = 0;
  if (!grid_blocks) {
    int dev = 0, cus = 0, per_cu = 0;
    (void)hipGetDevice(&dev);
    (void)hipDeviceGetAttribute(&cus, hipDeviceAttributeMultiprocessorCount, dev);
    (void)hipFuncSetAttribute((const void*)fwd_megakernel, hipFuncAttributeMaxDynamicSharedMemorySize, (int)kDynLds);
    (void)hipOccupancyMaxActiveBlocksPerMultiprocessor(&per_cu, (const void*)fwd_megakernel, 512, kDynLds);
    if (per_cu < 1) per_cu = 1;
    if (per_cu > 1) per_cu = 1;
    grid_blocks = cus * per_cu;
    if (ws_size < WS_END) fprintf(stderr, "kernel_launch: workspace too small: %zu < %zu\n", ws_size, (size_t)WS_END);
  }
  Params p{};
  p.x = (const float*)d_in[0]; p.c = (const float*)d_in[1]; p.ctx = (const float*)d_in[2]; p.c_ctx = (const float*)d_in[3];
  p.ada_w = (const float*)d_in[4]; p.ada_b = (const float*)d_in[5]; p.ln_g = (const float*)d_in[6]; p.ln_b = (const float*)d_in[7];
  p.w1 = (const float*)d_in[8]; p.w2 = (const float*)d_in[9]; p.w_in = (const float*)d_in[10]; p.conv_w = (const float*)d_in[11];
  p.lam_qk = (const float*)d_in[12]; p.subln_g = (const float*)d_in[13]; p.w_out_mix = (const float*)d_in[14]; p.w_out_f = (const float*)d_in[15];
  p.out = (float*)d_out; p.ws = (unsigned char*)d_ws;
  void* args[] = {&p};
  hipError_t e = hipLaunchCooperativeKernel((void*)fwd_megakernel, dim3(grid_blocks), dim3(512), args, kDynLds, stream);
  if (e != hipSuccess) fprintf(stderr, "cooperative launch failed: %s (grid %d)\n", hipGetErrorString(e), grid_blocks);
}
```

```cpp
#include <hip/hip_runtime.h>
#include <hip/hip_cooperative_groups.h>
#include <cstdio>
namespace cg = cooperative_groups;
#ifndef REP_P0
#define REP_P0 1
#endif
#ifndef REP_ATT
#define REP_ATT 1
#endif
#ifndef REP_GEMM
#define REP_GEMM 1
#endif
#ifndef REP_E1A
#define REP_E1A 1
#endif
#ifndef REP_E1V
#define REP_E1V 1
#endif
#ifndef REP_E3L
#define REP_E3L 1
#endif
#ifndef REP_E3C
#define REP_E3C 1
#endif
#ifndef REP_O1
#define REP_O1 1
#endif
#ifndef REP_O2L
#define REP_O2L 1
#endif
#ifndef REP_O2C
#define REP_O2C 1
#endif
#ifndef REP_M1
#define REP_M1 1
#endif
#ifndef REP_M2L
#define REP_M2L 1
#endif
#ifndef REP_M2C
#define REP_M2C 1
#endif
#ifndef REP_SYNC
#define REP_SYNC 1
#endif

#define LAS __attribute__((address_space(3)))
#define DI __device__ __forceinline__
typedef unsigned short bf16_t;
typedef short bf16x8 __attribute__((ext_vector_type(8)));
typedef short s16x4 __attribute__((ext_vector_type(4)));
typedef float f32x4 __attribute__((ext_vector_type(4)));
typedef float f32x2 __attribute__((ext_vector_type(2)));
typedef float f32x16 __attribute__((ext_vector_type(16)));
typedef unsigned u32x4 __attribute__((ext_vector_type(4)));
typedef unsigned u32x2 __attribute__((ext_vector_type(2)));
typedef __bf16 bf2_t __attribute__((ext_vector_type(2)));

constexpr int TPB = 4352;
constexpr int NROW = 17408;
constexpr float ALPHA = 1.681792830507429f;

constexpr size_t WS_WIN = 0;
constexpr size_t WS_W1 = WS_WIN + 12582912;
constexpr size_t WS_W2 = WS_W1 + 33554432;
constexpr size_t WS_WOM = WS_W2 + 33554432;
constexpr size_t WS_W12 = WS_WOM + 4194304;
constexpr size_t WS_H = WS_W12 + 8388608;
constexpr size_t WS_U = WS_H + 71303168;
constexpr size_t WS_Y = WS_U + 35651584;
constexpr size_t WS_BIG = WS_Y + 35651584;
constexpr size_t WS_P = WS_BIG;
constexpr size_t WS_QB = WS_BIG + 53477376;
constexpr size_t WS_KB = WS_QB + 17825792;
constexpr size_t WS_VT = WS_KB + 17825792;
constexpr size_t WS_MIX = WS_VT + 17825792;
constexpr size_t WS_HID = WS_BIG;
constexpr size_t WS_ZT = WS_BIG;
constexpr size_t WS_ZTC = WS_BIG + 67108864;
constexpr size_t WS_WT = WS_ZTC + 4194304;
constexpr size_t WS_MODP = WS_BIG + 142606336;
constexpr size_t WS_MOD = WS_MODP + 7864320;
constexpr size_t WS_ROPE = WS_MOD + 491520;
constexpr size_t WS_DN256 = WS_ROPE + 8192;
constexpr size_t WS_BAR = WS_DN256 + 262144;
constexpr size_t WS_DN2 = WS_BAR + 16384;
constexpr size_t WS_END = WS_DN2 + 262144;

struct Params {
  const float *x, *c, *ctx, *c_ctx, *ada_w, *ada_b, *ln_g, *ln_b, *w1, *w2, *w_in, *conv_w, *lam_qk, *subln_g, *w_out_mix, *w_out_f;
  float* out; unsigned char* ws;
};

DI unsigned pk2(float a, float b) { f32x2 v = {a, b}; bf2_t r = __builtin_convertvector(v, bf2_t); return __builtin_bit_cast(unsigned, r); }
DI float bflo(unsigned w) { return __uint_as_float(w << 16); }
DI float bfhi(unsigned w) { return __uint_as_float(w & 0xffff0000u); }
DI float wave_sum(float v) {
#pragma unroll
  for (int o = 32; o >= 1; o >>= 1) v += __shfl_xor(v, o);
  return v;
}


#define XB_TMO      128
#define XB_XCNT(j)  (256  + 64 * (j))
#define XB_XSUB(j)  (1280 + 64 * (j))
#define XB_XGEN(j)  (2304 + 64 * (j))
#define XB_TOP      3328
#define XB_TOPGEN   3392
#define XCD_BAR_WORDS 3456
#define XB_SPIN_CAP (1u << 20)
DI unsigned xb_ld(unsigned* p)              { return __hip_atomic_load(p, __ATOMIC_RELAXED, __HIP_MEMORY_SCOPE_AGENT); }
DI unsigned xb_add(unsigned* p, unsigned v) { return __hip_atomic_fetch_add(p, v, __ATOMIC_RELAXED, __HIP_MEMORY_SCOPE_AGENT); }
DI unsigned xb_xcc_id() { return (unsigned)__builtin_amdgcn_s_getreg((3 << 11) | 20) & 0xFu; }
#define XB_SPIN(cond, bar) do { unsigned _sp = 0; while (cond) { __builtin_amdgcn_s_sleep(1); \
    if ((++_sp & 255u) == 0u) { if (xb_ld(&(bar)[XB_TMO])) break; if (_sp > XB_SPIN_CAP) { atomicAdd(&(bar)[XB_TMO], 1u); break; } } } } while (0)
struct XcdBarrier { unsigned* bar; unsigned x; volatile LAS unsigned* st; };
DI XcdBarrier xcd_barrier_post(unsigned* bar, volatile LAS unsigned* st) {
  XcdBarrier b; b.bar = bar; b.x = xb_xcc_id(); b.st = st;
  if (threadIdx.x == 0) (void)xb_add(&bar[XB_XCNT(b.x)], 1u);
  return b;
}
DI void xcd_barrier_complete(unsigned* bar, unsigned x, unsigned& nloc, unsigned& nx) {
  const unsigned G = gridDim.x * gridDim.y * gridDim.z;
  unsigned sum, cnt, mine, sp = 0u;
  for (;;) {
    sum = 0u; cnt = 0u; mine = 0u;
#pragma unroll
    for (unsigned j = 0; j < 16; ++j) { const unsigned c = xb_ld(&bar[XB_XCNT(j)]); sum += c; cnt += (c > 0u) ? 1u : 0u; mine = (j == x) ? c : mine; }
    if (sum == G) break;
    __builtin_amdgcn_s_sleep(1);
    if ((++sp & 255u) == 0u) { if (xb_ld(&bar[XB_TMO])) break; if (sp > XB_SPIN_CAP) { atomicAdd(&bar[XB_TMO], 1u); break; } }
  }
  nloc = mine > 0u ? mine : 1u; nx = cnt > 0u ? cnt : 1u;
}
DI void xcd_barrier(const XcdBarrier& b) {
  asm volatile("s_waitcnt vmcnt(0)" ::: "memory");
  __syncthreads();
  if (threadIdx.x == 0) {
    unsigned* bar = b.bar;
    __builtin_amdgcn_s_waitcnt(0);
    unsigned nloc = b.st[0], nx = b.st[1];
    if (nloc == 0u) { xcd_barrier_complete(bar, b.x, nloc, nx); b.st[0] = nloc; b.st[1] = nx; }
    const unsigned old = xb_add(&bar[XB_XSUB(b.x)], 1u);
    const unsigned gen = old / nloc;
    if (old + 1u == (gen + 1u) * nloc) {
      __builtin_amdgcn_fence(__ATOMIC_RELEASE, "agent");
      asm volatile("s_waitcnt vmcnt(0)" ::: "memory");
      const unsigned og = xb_add(&bar[XB_TOP], 1u);
      const unsigned tg = og / nx;
      if (og + 1u == (tg + 1u) * nx) xb_add(&bar[XB_TOPGEN], 1u);
      else XB_SPIN(xb_ld(&bar[XB_TOPGEN]) == tg, bar);
      __builtin_amdgcn_fence(__ATOMIC_ACQUIRE, "agent");
      xb_add(&bar[XB_XGEN(b.x)], 1u);
      asm volatile("s_waitcnt vmcnt(0)" ::: "memory");
    } else {
      XB_SPIN(xb_ld(&bar[XB_XGEN(b.x)]) == gen, bar);
      __builtin_amdgcn_fence(__ATOMIC_ACQUIRE, "agent");
      asm volatile("s_waitcnt vmcnt(0)" ::: "memory");
    }
  }
  __syncthreads();
}

constexpr int BM = 256, BK = 64, HALF = 128, HTB = HALF * BK * 2, STAGE_BYTES = 8 * HTB, NXCD = 8, WGM = 8;
DI int lds_byte(int r, int c) { const int st = (r >> 4) * 2 + (c >> 5), rr = r & 15, cc = c & 31, ob = rr * 64 + cc * 2; return st * 1024 + (ob ^ (((ob >> 9) & 1) << 5)); }
DI void stage_rc(int b, int& R, int& C) { const int st = b / 1024, sb = b % 1024, swz = sb ^ (((sb >> 9) & 1) << 5); R = (st >> 1) * 16 + swz / 64; C = (st & 1) * 32 + (swz % 64) / 2; }
DI int perm32(int rho) { const int n = rho >> 4, i = rho & 15; return 8 * (i >> 2) + 4 * n + (i & 3); }

struct Unit { int pm, pn; };
struct Gemm { const bf16_t* A; const bf16_t* Bt; int M, N, K; int mode; int a_mod; size_t bstride; int lda, ldb; };

struct StaticOrder {
  int nM, nN, nwg, G, c;
  DI void init(int M, int N, int G_, int c_) { nM = M / BM; nN = N / BM; nwg = nM * nN; G = G_; c = c_; }
  DI bool next(int i, Unit& u) const {
    const long L = (long)i * G + c; if (L >= nwg) return false;
    int wgid = (int)L; { const int q = nwg / NXCD, r = nwg % NXCD, xcd = wgid % NXCD, off = wgid / NXCD; wgid = (xcd < r ? xcd * (q + 1) : r * (q + 1) + (xcd - r) * q) + off; }
    const int nig = WGM * nN, gid = wgid / nig, fm = gid * WGM, gsz = (nM - fm) < WGM ? (nM - fm) : WGM;
    u.pm = fm + ((wgid % nig) % gsz); u.pn = (wgid % nig) / gsz; return true;
  }
};

DI void unit_ptrs(const Gemm& g, const Unit& v, size_t tstepA, size_t tstepB, const char*& cA, const char*& cB, Unit& real) {
  int pm = v.pm, pn = v.pn, pa = v.pm, pb = v.pn; size_t boff = 0, aoff = 0;
  if (g.mode == 1) { pm = pm + pm / 16; pa = pm; }
  else if (g.mode == 2) { pn = pn + pn / 16; pb = pn; }
  else if (g.mode == 3) { pa = pm % g.a_mod; boff = (size_t)(pm / g.a_mod) * g.bstride; }
  else if (g.mode == 4) { const int bb = pm / g.a_mod, ks = pm % g.a_mod; pa = 0; aoff = ((size_t)(bb * TPB + 4096) * g.lda + (size_t)ks * 256) * 2; boff = (size_t)ks * 512; }
  cA = (const char*)g.A + aoff + (size_t)pa * tstepA; cB = (const char*)g.Bt + boff + (size_t)pb * tstepB; real.pm = pm; real.pn = pn;
}

template <class Epi>
DI void gemm_phase(LAS unsigned char* lds, const Gemm g, const Epi& E) {
  int tid = threadIdx.x; asm volatile("" : "+v"(tid));
  const int wid = __builtin_amdgcn_readfirstlane(tid >> 6), lane = tid & 63, wr = wid >> 2, wc = wid & 3, fr = lane & 15, fq = lane >> 4;
  const int K = g.K, nt = K / BK;
  StaticOrder S; S.init(g.M, g.N, (int)gridDim.x, (int)blockIdx.x);
  unsigned voffA[2], voffB[2];
#pragma unroll
  for (int i = 0; i < 2; ++i) { int R, C; stage_rc(tid * 16 + i * 8192, R, C); const int Rb = Epi::PERM ? ((R & ~31) + perm32(R & 31)) : R;
    voffA[i] = (unsigned)(R * g.lda + C) * 2u; voffB[i] = (unsigned)(Rb * g.ldb + C) * 2u; }
  const size_t kstep = (size_t)(BK * 2);
  const size_t hstepA = (size_t)HALF * g.lda * 2, hstepB = (size_t)HALF * g.ldb * 2;
  const size_t tstepA = 2 * hstepA, tstepB = 2 * hstepB;
  const unsigned ldsw = (unsigned)wid * 1024u;
  const int aoff = lds_byte(wr * 64 + fr, fq * 8), boff = lds_byte(wc * 32 + fr, fq * 8);
#define PG8_SA(b, h) (((b) * 2 + (h)) * HTB)
#define PG8_SB(b, h) ((4 + (b) * 2 + (h)) * HTB)
#define PG8_STAGE(bufoff, gbase, voff) do { _Pragma("unroll") for (int _i = 0; _i < 2; ++_i) \
        __builtin_amdgcn_global_load_lds((const unsigned*)((const char*)(gbase) + (voff)[_i]), (LAS unsigned*)(lds + (bufoff) + ldsw + _i * 8192), 16, 0, 0); } while (0)
#define PG8_LDA(dst, b, h) do { _Pragma("unroll") for (int m = 0; m < 4; ++m) _Pragma("unroll") for (int k = 0; k < 2; ++k) dst[m][k] = *(const LAS bf16x8*)(lds + PG8_SA(b, h) + aoff + m * 2048 + k * 1024); } while (0)
#define PG8_LDB(dst, b, h) do { _Pragma("unroll") for (int n = 0; n < 2; ++n) _Pragma("unroll") for (int k = 0; k < 2; ++k) dst[n][k] = *(const LAS bf16x8*)(lds + PG8_SB(b, h) + boff + n * 2048 + k * 1024); } while (0)
#define PG8_MMA(ai, bj, At, Bt) do { __builtin_amdgcn_s_setprio(1); _Pragma("unroll") for (int m = 0; m < 4; ++m) _Pragma("unroll") for (int n = 0; n < 2; ++n) _Pragma("unroll") for (int k = 0; k < 2; ++k) \
        acc[ai][bj][m][n] = __builtin_amdgcn_mfma_f32_16x16x32_bf16(Bt[n][k], At[m][k], acc[ai][bj][m][n], 0, 0, 0); __builtin_amdgcn_s_setprio(0); } while (0)
#define PG8_WAIT_V(n) asm volatile("s_waitcnt vmcnt(" #n ")" ::: "memory")
#define PG8_WAIT_L(n) asm volatile("s_waitcnt lgkmcnt(" #n ")" ::: "memory")
#define PG8_BAR __builtin_amdgcn_s_barrier()
#define PG8_SCHED __builtin_amdgcn_sched_barrier(0)
  Unit cur, nxt, curR, nxtR; int ui = 0;
  if (!S.next(0, cur)) return;
  f32x4 acc[2][2][4][2];
#pragma unroll
  for (int a = 0; a < 2; ++a)
#pragma unroll
    for (int b = 0; b < 2; ++b)
#pragma unroll
      for (int m = 0; m < 4; ++m)
#pragma unroll
        for (int n = 0; n < 2; ++n) acc[a][b][m][n] = (f32x4){0.f, 0.f, 0.f, 0.f};
  bf16x8 At[4][2], B0[2][2], B1[2][2];
  const char* cA; const char* cB;
  unit_ptrs(g, cur, tstepA, tstepB, cA, cB, curR);
  PG8_STAGE(PG8_SB(0, 0), cB, voffB); PG8_STAGE(PG8_SA(0, 0), cA, voffA); PG8_STAGE(PG8_SB(0, 1), cB + hstepB, voffB); PG8_STAGE(PG8_SA(0, 1), cA + hstepA, voffA);
  if (wr == 1) PG8_BAR;
  PG8_WAIT_V(4); PG8_BAR;
  PG8_STAGE(PG8_SB(1, 0), cB + kstep, voffB); PG8_STAGE(PG8_SA(1, 0), cA + kstep, voffA); PG8_STAGE(PG8_SB(1, 1), cB + hstepB + kstep, voffB);
  PG8_WAIT_V(6); PG8_BAR;
  for (;;) {
    const bool has_next = S.next(ui + 1, nxt);
    const char* nA = cA; const char* nB = cB; nxtR = curR;
    if (has_next) unit_ptrs(g, nxt, tstepA, tstepB, nA, nB, nxtR);
    for (int t = 0; t < nt; t += 2) {
      const bool last = (t == nt - 2);
      const char* a1 = cA + (size_t)(t + 1) * kstep;
      const char* a2 = last ? nA : cA + (size_t)(t + 2) * kstep; const char* b2 = last ? nB : cB + (size_t)(t + 2) * kstep;
      const char* a3 = a2 + kstep; const char* b3 = b2 + kstep;
      PG8_LDB(B0, 0, 0); PG8_SCHED; PG8_LDA(At, 0, 0); PG8_STAGE(PG8_SA(1, 1), a1 + hstepA, voffA);
      PG8_WAIT_L(8); PG8_BAR; PG8_WAIT_L(0); PG8_MMA(0, 0, At, B0); PG8_BAR; PG8_SCHED;
      PG8_LDB(B1, 0, 1); PG8_STAGE(PG8_SB(0, 0), b2, voffB);
      PG8_BAR; PG8_WAIT_L(0); PG8_MMA(0, 1, At, B1); PG8_BAR;
      PG8_LDA(At, 0, 1); PG8_STAGE(PG8_SA(0, 0), a2, voffA);
      PG8_BAR; PG8_WAIT_L(0); PG8_MMA(1, 0, At, B0); PG8_BAR; PG8_SCHED;
      PG8_STAGE(PG8_SB(0, 1), b2 + hstepB, voffB);
      PG8_WAIT_V(6); PG8_BAR; PG8_MMA(1, 1, At, B1); PG8_BAR;
      PG8_LDB(B0, 1, 0); PG8_SCHED; PG8_LDA(At, 1, 0); PG8_STAGE(PG8_SA(0, 1), a2 + hstepA, voffA);
      PG8_WAIT_L(8); PG8_BAR; PG8_WAIT_L(0); PG8_MMA(0, 0, At, B0); PG8_BAR; PG8_SCHED;
      PG8_LDB(B1, 1, 1); PG8_STAGE(PG8_SB(1, 0), b3, voffB);
      PG8_BAR; PG8_WAIT_L(0); PG8_MMA(0, 1, At, B1); PG8_BAR;
      PG8_LDA(At, 1, 1); PG8_STAGE(PG8_SA(1, 0), a3, voffA);
      PG8_BAR; PG8_WAIT_L(0); PG8_MMA(1, 0, At, B0); PG8_BAR; PG8_SCHED;
      PG8_STAGE(PG8_SB(1, 1), b3 + hstepB, voffB);
      PG8_WAIT_V(6); PG8_BAR; PG8_MMA(1, 1, At, B1); PG8_BAR;
    }
    E(acc, curR, wr, wc, fr, fq);
    if (!has_next) break;
#pragma unroll
    for (int a = 0; a < 2; ++a)
#pragma unroll
      for (int b = 0; b < 2; ++b)
#pragma unroll
        for (int m = 0; m < 4; ++m)
#pragma unroll
          for (int n = 0; n < 2; ++n) acc[a][b][m][n] = (f32x4){0.f, 0.f, 0.f, 0.f};
    cur = nxt; curR = nxtR; cA = nA; cB = nB; ++ui;
  }
  PG8_WAIT_V(0);
  if (wr == 0) PG8_BAR;
  PG8_BAR;
#undef PG8_SA
#undef PG8_SB
#undef PG8_STAGE
#undef PG8_LDA
#undef PG8_LDB
#undef PG8_MMA
#undef PG8_WAIT_V
#undef PG8_WAIT_L
#undef PG8_BAR
#undef PG8_SCHED
}

DI void store8(bf16_t* dst, const f32x4& a, const f32x4& b) {
  u32x4 w; w.x = pk2(a[0], a[1]); w.y = pk2(a[2], a[3]); w.z = pk2(b[0], b[1]); w.w = pk2(b[2], b[3]);
  *(u32x4*)dst = w;
}
enum { EP_PLAIN = 0, EP_RELU2 = 1, EP_QKC = 2, EP_VT = 3, EP_ZT = 4 };
template <int MODE> struct Epi {
  static constexpr bool PERM = true;
  bf16_t* O; bf16_t* O2; bf16_t* O3; const float* ropec; const float* ropes; int ldc; int rowmap; int aux;
  DI void operator()(const f32x4 (&acc)[2][2][4][2], const Unit& u, int wr, int wc, int fr, int fq) const {
    if constexpr (MODE == EP_PLAIN || MODE == EP_RELU2) {
      int rowbase = u.pm * 256;
      if (rowmap == 1) rowbase = (u.pm / 16) * TPB + (u.pm % 16) * 256;
      else if (rowmap == 2) rowbase = u.pm * TPB + 4096;
      const int rmul = (rowmap == 3) ? 16 : 1;
      if (rowmap == 3) rowbase = (u.pm / 16) * TPB + (u.pm % 16);
      if (rowmap == 4) rowbase = (u.pm % aux) * 1024 + (u.pm / aux) * 256;
#pragma unroll
      for (int ai = 0; ai < 2; ++ai)
#pragma unroll
        for (int m = 0; m < 4; ++m) {
          const size_t row = (size_t)(rowbase + rmul * (ai * 128 + wr * 64 + m * 16 + fr));
#pragma unroll
          for (int bj = 0; bj < 2; ++bj) {
            const int col = u.pn * 256 + bj * 128 + wc * 32 + 8 * fq;
            f32x4 v0 = acc[ai][bj][m][0], v1 = acc[ai][bj][m][1];
            if constexpr (MODE == EP_RELU2) {
#pragma unroll
              for (int e = 0; e < 4; ++e) { float a = fmaxf(v0[e], 0.f), b = fmaxf(v1[e], 0.f); v0[e] = a * a; v1[e] = b * b; }
            }
            store8(O + row * ldc + col, v0, v1);
          }
        }
    } else if constexpr (MODE == EP_QKC) {
      const int pn = u.pn, b = u.pm / 17, pmr = u.pm % 17; const bool latent = pmr < 16;
#pragma unroll
      for (int ai = 0; ai < 2; ++ai)
#pragma unroll
        for (int m = 0; m < 4; ++m) {
          const int t = pmr * 256 + ai * 128 + wr * 64 + m * 16 + fr;
          const size_t row = (size_t)b * TPB + t;
#pragma unroll
          for (int bj = 0; bj < 2; ++bj) {
            const int col = pn * 256 + bj * 128 + wc * 32 + 8 * fq;
            f32x4 v0 = acc[ai][bj][m][0], v1 = acc[ai][bj][m][1];
            if (pn < 6) { store8(O + row * 1536 + col, v0, v1); }
            else {
              if (latent) {
                const int pos = (wc & 1) ? (t & 63) : (t >> 6);
                const float* cp = ropec + pos * 16 + 8 * (fq & 1); const float* sp = ropes + pos * 16 + 8 * (fq & 1);
                const f32x4 c0 = *(const f32x4*)cp, c1 = *(const f32x4*)(cp + 4), s0 = *(const f32x4*)sp, s1 = *(const f32x4*)(sp + 4);
                const float sgn = (fq < 2) ? -1.f : 1.f;
#pragma unroll
                for (int e = 0; e < 4; ++e) {
                  const float p0 = __shfl_xor(v0[e], 32), p1 = __shfl_xor(v1[e], 32);
                  v0[e] = v0[e] * c0[e] + sgn * p0 * s0[e];
                  v1[e] = v1[e] * c1[e] + sgn * p1 * s1[e];
                }
              }
              if (pn < 8) { store8(O2 + row * 512 + (col - 1536), v0, v1); }
              else {
                const int head = (pn - 8) * 2 + bj, comp = wc >> 1, d0 = (wc & 1) * 32 + 8 * fq;
                store8(O3 + ((size_t)((b * 4 + head) * 2 + comp) * TPB + t) * 64 + d0, v0, v1);
              }
            }
          }
        }
    } else if constexpr (MODE == EP_VT) {
      const int b = u.pn / 17, pnr = u.pn % 17;
#pragma unroll
      for (int ai = 0; ai < 2; ++ai)
#pragma unroll
        for (int m = 0; m < 4; ++m) {
          const int n = u.pm * 256 + ai * 128 + wr * 64 + m * 16 + fr; const int head = n >> 7, dv = n & 127;
#pragma unroll
          for (int bj = 0; bj < 2; ++bj) {
            const int t = pnr * 256 + bj * 128 + wc * 32 + 8 * fq;
            store8(O + ((size_t)((b * 4 + head) * 128 + dv)) * TPB + t, acc[ai][bj][m][0], acc[ai][bj][m][1]);
          }
        }
    } else {
      const int b = u.pn / 17, pnr = u.pn % 17;
#pragma unroll
      for (int ai = 0; ai < 2; ++ai)
#pragma unroll
        for (int m = 0; m < 4; ++m) {
          const int n = u.pm * 256 + ai * 128 + wr * 64 + m * 16 + fr; const int part = n >> 10, ch = n & 1023;
#pragma unroll
          for (int bj = 0; bj < 2; ++bj) {
            const int tt = pnr * 256 + bj * 128 + wc * 32 + 8 * fq;
            bf16_t* dst = (pnr < 16) ? O + ((size_t)(b * 1024 + ch)) * 8192 + part * 4096 + tt
                                     : O2 + ((size_t)(b * 1024 + ch)) * 512 + part * 256 + (tt - 4096);
            store8(dst, acc[ai][bj][m][0], acc[ai][bj][m][1]);
          }
        }
    }
  }
};

DI void tr_item(LAS float* tile, const float* src, bf16_t* dst, int K, int N, int tk, int tn) {
  const int tid = threadIdx.x;
#pragma unroll
  for (int i = 0; i < 2; ++i) {
    const int k = (tid >> 4) + 32 * i, n4 = (tid & 15) * 4;
    const f32x4 v = *(const f32x4*)(src + (size_t)(tk * 64 + k) * N + tn * 64 + n4);
    tile[k * 65 + n4 + 0] = v[0]; tile[k * 65 + n4 + 1] = v[1]; tile[k * 65 + n4 + 2] = v[2]; tile[k * 65 + n4 + 3] = v[3];
  }
  __syncthreads();
  const int n = tid >> 3, k0 = (tid & 7) * 8;
  float e[8];
#pragma unroll
  for (int i = 0; i < 8; ++i) e[i] = tile[(k0 + i) * 65 + n];
  u32x4 w; w.x = pk2(e[0], e[1]); w.y = pk2(e[2], e[3]); w.z = pk2(e[4], e[5]); w.w = pk2(e[6], e[7]);
  *(u32x4*)(dst + (size_t)(tn * 64 + n) * K + tk * 64 + k0) = w;
  __syncthreads();
}

DI void w12_item(LAS float* trig, const Params& p, int it) {
  const int tid = threadIdx.x;
  const int nh = it & 1, part = (it >> 1) & 1, co = (it >> 2) & 15, g = (it >> 6) & 7, j = it >> 9;
  if (tid < 128) { const float f = (float)tid * (1.0f / 128.0f); trig[tid] = __builtin_amdgcn_cosf(f); trig[128 + tid] = __builtin_amdgcn_sinf(f); }
  __syncthreads();
  const int n = nh * 512 + tid, c0 = co * 8;
  const float* W = p.w_out_f + (size_t)j * 1048576 + (size_t)(g * 128) * 1024 + n;
  float acc[8];
#pragma unroll
  for (int e = 0; e < 8; ++e) acc[e] = 0.f;
  for (int kc = 0; kc < 128; ++kc) {
    const float w = W[(size_t)kc * 1024];
#pragma unroll
    for (int e = 0; e < 8; ++e) acc[e] += w * trig[part * 128 + (((c0 + e) * kc) & 127)];
  }
  const float sc = 0.08838834764831845f;
  u32x4 o; o.x = pk2(acc[0] * sc, acc[1] * sc); o.y = pk2(acc[2] * sc, acc[3] * sc); o.z = pk2(acc[4] * sc, acc[5] * sc); o.w = pk2(acc[6] * sc, acc[7] * sc);
  bf16_t* dst = (bf16_t*)(p.ws + WS_W12) + (size_t)j * 2097152 + (size_t)(part * 1024 + n) * 1024 + g * 128 + c0;
  *(u32x4*)dst = o;
  __syncthreads();
}

DI void dn256_item(bf16_t* Dn, int it, float sgn, float scale) {
  const int idx0 = it * 512 + threadIdx.x, k = idx0 >> 6, col0 = (idx0 & 63) * 8, half = col0 >> 8, n0 = col0 & 255;
  float v[8];
#pragma unroll
  for (int e = 0; e < 8; ++e) {
    const int idx = (k * (n0 + e)) & 255; const float f = (float)idx * (1.0f / 256.0f);
    v[e] = (half ? sgn * __builtin_amdgcn_sinf(f) : __builtin_amdgcn_cosf(f)) * scale;
  }
  u32x4 o; o.x = pk2(v[0], v[1]); o.y = pk2(v[2], v[3]); o.z = pk2(v[4], v[5]); o.w = pk2(v[6], v[7]);
  *(u32x4*)(Dn + (size_t)k * 512 + col0) = o;
}
DI void rope_item(float* tab) {
#pragma unroll
  for (int i = 0; i < 2; ++i) {
    const int e = threadIdx.x + 512 * i, pos = e >> 4, fi = e & 15;
    const float inv = __builtin_amdgcn_exp2f(-(float)fi * (13.287712379549449f / 16.0f));
    const float ang = (float)pos * inv; float rev = ang * 0.15915494309189535f; rev = rev - floorf(rev);
    tab[e] = __builtin_amdgcn_cosf(rev); tab[1024 + e] = __builtin_amdgcn_sinf(rev);
  }
}
DI void modp_item(LAS float* sm, const Params& p, int it) {
  const int tid = threadIdx.x, layer = it / 96, rem = it % 96, cb = rem / 16, kc = rem % 16;
  LAS float* scv = sm;
  LAS float* red = sm + 320;
  if (tid < 320) { const int cond = tid >> 6, kk = tid & 63, k = kc * 64 + kk; const float v = cond < 4 ? p.c[cond * 1024 + k] : p.c_ctx[k];
    scv[tid] = v / (1.0f + __builtin_amdgcn_exp2f(-v * 1.4426950408889634f)); }
  __syncthreads();
  const int c4 = tid & 255, kh = tid >> 8;
  f32x4 acc[5];
#pragma unroll
  for (int cnd = 0; cnd < 5; ++cnd) acc[cnd] = (f32x4){0.f, 0.f, 0.f, 0.f};
  const float* wp = p.ada_w + ((size_t)layer * 1024 + kc * 64 + kh * 32) * 6144 + cb * 1024 + c4 * 4;
  for (int kk = 0; kk < 32; ++kk) {
    const f32x4 w = *(const f32x4*)(wp + (size_t)kk * 6144);
#pragma unroll
    for (int cnd = 0; cnd < 5; ++cnd) acc[cnd] += w * scv[cnd * 64 + kh * 32 + kk];
  }
  if (kh == 1) {
#pragma unroll
    for (int cnd = 0; cnd < 5; ++cnd) *(LAS f32x4*)(red + (cnd * 256 + c4) * 4) = acc[cnd];
  }
  __syncthreads();
  if (kh == 0) {
    float* mp = (float*)(p.ws + WS_MODP);
#pragma unroll
    for (int cnd = 0; cnd < 5; ++cnd) {
      const f32x4 o = acc[cnd] + *(const LAS f32x4*)(red + (cnd * 256 + c4) * 4);
      *(f32x4*)(mp + ((size_t)((kc * 4 + layer) * 5 + cnd)) * 6144 + cb * 1024 + c4 * 4) = o;
    }
  }
  __syncthreads();
}

DI void phase0(LAS unsigned char* lds, const Params& p) {
  LAS float* smf = (LAS float*)lds;
  constexpr int N_TR = 10240, N_W12 = 1024, N_DN = 32, N_D256 = 32, N_ROPE = 1, N_MODP = 384;
  constexpr int TOT = N_TR + N_W12 + N_DN + N_D256 + N_ROPE + N_MODP;
  for (int it = blockIdx.x; it < TOT; it += gridDim.x) {
    int i = it;
    if (i < N_MODP) { modp_item(smf, p, i); continue; }
    i -= N_MODP;
    if (i < N_W12) { w12_item(smf, p, i); continue; }
    i -= N_W12;
    if (i < N_TR) {
      if (i < 1536) { const int j = i / 768, rem = i % 768; tr_item(smf, p.w_in + (size_t)j * 3145728, (bf16_t*)(p.ws + WS_WIN) + (size_t)j * 3145728, 1024, 3072, rem / 48, rem % 48); }
      else if (i < 5632) { const int q = i - 1536, l = q / 1024, rem = q % 1024; tr_item(smf, p.w1 + (size_t)l * 4194304, (bf16_t*)(p.ws + WS_W1) + (size_t)l * 4194304, 1024, 4096, rem / 64, rem % 64); }
      else if (i < 9728) { const int q = i - 5632, l = q / 1024, rem = q % 1024; tr_item(smf, p.w2 + (size_t)l * 4194304, (bf16_t*)(p.ws + WS_W2) + (size_t)l * 4194304, 4096, 1024, rem / 16, rem % 16); }
      else { const int q = i - 9728, j = q / 256, rem = q % 256; tr_item(smf, p.w_out_mix + (size_t)j * 1048576, (bf16_t*)(p.ws + WS_WOM) + (size_t)j * 1048576, 1024, 1024, rem / 16, rem % 16); }
      continue;
    }
    i -= N_TR;
    if (i < N_DN) { dn256_item((bf16_t*)(p.ws + WS_DN2), i, 1.0f, 1.0f / 64.0f); continue; }
    i -= N_DN;
    if (i < N_D256) { dn256_item((bf16_t*)(p.ws + WS_DN256), i, -1.0f, 1.0f / 16.0f); continue; }
    rope_item((float*)(p.ws + WS_ROPE));
  }
}

DI void phase0b(const Params& p) {
  const float* mp = (const float*)(p.ws + WS_MODP); float* mod = (float*)(p.ws + WS_MOD);
  for (int i = blockIdx.x * 512 + threadIdx.x; i < 30720; i += gridDim.x * 512) {
    const int e = i * 4, layer = e / 30720, col = e % 6144;
    f32x4 a = *(const f32x4*)(p.ada_b + layer * 6144 + col);
#pragma unroll
    for (int kc = 0; kc < 16; ++kc) a += *(const f32x4*)(mp + (size_t)kc * 122880 + e);
    *(f32x4*)(mod + e) = a;
  }
}

DI void ln_pass(const Params& p, bool first, const float* gate, const float* lng, const float* lnb, const float* nsh, const float* nsc, bool last, bool lat_only, int nks) {
  int tid = threadIdx.x; asm volatile("" : "+v"(tid));
  const int wave = tid >> 6, lane = tid & 63;
  float* H = (float*)(p.ws + WS_H); const bf16_t* Y = (const bf16_t*)(p.ws + WS_Y); bf16_t* U = (bf16_t*)(p.ws + WS_U);
  const int npairs = (lat_only ? 16384 : NROW) / 2;
  for (int pi = blockIdx.x * 8 + wave; pi < npairs; pi += gridDim.x * 8) {
    const int rv = pi * 2;
    int b, t;
    if (lat_only) { b = rv >> 12; t = rv & 4095; } else { b = rv / TPB; t = rv % TPB; }
    const size_t r = (size_t)b * TPB + t; const int cond = t < 4096 ? b : 4;
    float v[2][16];
    if (first) {
      const float* src = t < 4096 ? p.x + ((size_t)(b * 4096 + t)) * 1024 : p.ctx + ((size_t)(b * 256 + t - 4096)) * 1024;
#pragma unroll
      for (int z = 0; z < 2; ++z)
#pragma unroll
        for (int q = 0; q < 4; ++q) { const f32x4 a = *(const f32x4*)(src + z * 1024 + q * 256 + lane * 4); v[z][4 * q] = a[0]; v[z][4 * q + 1] = a[1]; v[z][4 * q + 2] = a[2]; v[z][4 * q + 3] = a[3]; }
    } else {
      const float* hr = H + r * 1024; const bf16_t* yr = Y + r * 1024; const float* gr = gate + cond * 6144;
      f32x4 ha[2][4]; f32x4 yv[2][4];
#pragma unroll
      for (int z = 0; z < 2; ++z)
#pragma unroll
        for (int q = 0; q < 4; ++q) { const int c = z * 1024 + q * 256 + lane * 4; ha[z][q] = *(const f32x4*)(hr + c); }
      if (nks > 0 && t >= 4096) {
        const bf16_t* pr = (const bf16_t*)p.out + ((size_t)(b * 256 + t - 4096)) * 1024;
#pragma unroll
        for (int z = 0; z < 2; ++z)
#pragma unroll
          for (int q = 0; q < 4; ++q) yv[z][q] = (f32x4){0.f, 0.f, 0.f, 0.f};
        for (int ks = 0; ks < nks; ++ks) {
#pragma unroll
          for (int z = 0; z < 2; ++z)
#pragma unroll
            for (int q = 0; q < 4; ++q) { const u32x2 w = *(const u32x2*)(pr + (size_t)ks * 1048576 + z * 1024 + q * 256 + lane * 4);
              yv[z][q][0] += bflo(w.x); yv[z][q][1] += bfhi(w.x); yv[z][q][2] += bflo(w.y); yv[z][q][3] += bfhi(w.y); }
        }
      } else {
#pragma unroll
        for (int z = 0; z < 2; ++z)
#pragma unroll
          for (int q = 0; q < 4; ++q) { const u32x2 w = *(const u32x2*)(yr + z * 1024 + q * 256 + lane * 4); yv[z][q] = (f32x4){bflo(w.x), bfhi(w.x), bflo(w.y), bfhi(w.y)}; }
      }
      float s[2] = {0.f, 0.f};
#pragma unroll
      for (int q = 0; q < 4; ++q) {
        const f32x4 g = *(const f32x4*)(gr + q * 256 + lane * 4);
#pragma unroll
        for (int z = 0; z < 2; ++z) {
#pragma unroll
          for (int e = 0; e < 4; ++e) v[z][4 * q + e] = ALPHA * ha[z][q][e] + g[e] * yv[z][q][e];
          s[z] += v[z][4 * q] + v[z][4 * q + 1] + v[z][4 * q + 2] + v[z][4 * q + 3];
        }
      }
      float mu[2], rstd[2];
#pragma unroll
      for (int z = 0; z < 2; ++z) mu[z] = wave_sum(s[z]) * (1.0f / 1024.0f);
#pragma unroll
      for (int z = 0; z < 2; ++z) { float ss = 0.f;
#pragma unroll
        for (int e = 0; e < 16; ++e) { const float d = v[z][e] - mu[z]; ss += d * d; }
        s[z] = ss; }
#pragma unroll
      for (int z = 0; z < 2; ++z) rstd[z] = __builtin_amdgcn_rsqf(wave_sum(s[z]) * (1.0f / 1024.0f) + 1e-6f);
#pragma unroll
      for (int q = 0; q < 4; ++q) {
        const int c = q * 256 + lane * 4;
        const f32x4 g = *(const f32x4*)(lng + c), bb = *(const f32x4*)(lnb + c);
#pragma unroll
        for (int z = 0; z < 2; ++z)
#pragma unroll
          for (int e = 0; e < 4; ++e) v[z][4 * q + e] = (v[z][4 * q + e] - mu[z]) * rstd[z] * g[e] + bb[e];
      }
    }
    float* dst = last ? p.out + ((size_t)(b * 4096 + t)) * 1024 : H + r * 1024;
#pragma unroll
    for (int z = 0; z < 2; ++z)
#pragma unroll
      for (int q = 0; q < 4; ++q) *(f32x4*)(dst + z * 1024 + q * 256 + lane * 4) = (f32x4){v[z][4 * q], v[z][4 * q + 1], v[z][4 * q + 2], v[z][4 * q + 3]};
    if (!last) {
      float s[2], mu[2], rstd[2];
#pragma unroll
      for (int z = 0; z < 2; ++z) { float a = 0.f;
#pragma unroll
        for (int e = 0; e < 16; ++e) a += v[z][e];
        s[z] = a; }
#pragma unroll
      for (int z = 0; z < 2; ++z) mu[z] = wave_sum(s[z]) * (1.0f / 1024.0f);
#pragma unroll
      for (int z = 0; z < 2; ++z) { float ss = 0.f;
#pragma unroll
        for (int e = 0; e < 16; ++e) { const float d = v[z][e] - mu[z]; ss += d * d; }
        s[z] = ss; }
#pragma unroll
      for (int z = 0; z < 2; ++z) rstd[z] = __builtin_amdgcn_rsqf(wave_sum(s[z]) * (1.0f / 1024.0f) + 1e-6f);
      const float* shr = nsh + cond * 6144; const float* scr = nsc + cond * 6144;
#pragma unroll
      for (int q = 0; q < 4; ++q) {
        const int c = q * 256 + lane * 4;
        const f32x4 sh = *(const f32x4*)(shr + c), sc = *(const f32x4*)(scr + c);
#pragma unroll
        for (int z = 0; z < 2; ++z) {
          float o[4];
#pragma unroll
          for (int e = 0; e < 4; ++e) o[e] = (v[z][4 * q + e] - mu[z]) * rstd[z] * (1.0f + sc[e]) + sh[e];
          u32x2 w; w.x = pk2(o[0], o[1]); w.y = pk2(o[2], o[3]);
          *(u32x2*)(U + (r + z) * 1024 + c) = w;
        }
      }
    }
  }
}


DI void dft4(float& r0, float& i0, float& r1, float& i1, float& r2, float& i2, float& r3, float& i3) {
  const float t0r = r0 + r2, t0i = i0 + i2, t1r = r0 - r2, t1i = i0 - i2, t2r = r1 + r3, t2i = i1 + i3, t3r = r1 - r3, t3i = i1 - i3;
  r0 = t0r + t2r; i0 = t0i + t2i; r2 = t0r - t2r; i2 = t0i - t2i;
  r1 = t1r + t3i; i1 = t1i - t3r; r3 = t1r - t3i; i3 = t1i + t3r;
}
DI void fft16_pass(const Params& p) {
  int tid = threadIdx.x; asm volatile("" : "+v"(tid));
  const bf16_t* Zt = (const bf16_t*)(p.ws + WS_ZT); bf16_t* Wt = (bf16_t*)(p.ws + WS_WT);
  const int sub = tid >> 7, np = tid & 127, n1 = np * 2;
  for (int it = blockIdx.x; it < 1024; it += gridDim.x) {
    const int bc = it * 4 + sub, b = bc >> 10, ch = bc & 1023;
    const bf16_t* zr = Zt + (size_t)bc * 8192 + n1;
    unsigned ga[16], gb[16];
#pragma unroll
    for (int n2 = 0; n2 < 16; ++n2) { ga[n2] = *(const unsigned*)(zr + 256 * n2); gb[n2] = *(const unsigned*)(zr + 4096 + 256 * n2); }
    float outr[2][16], outi[2][16];
#pragma unroll
    for (int z = 0; z < 2; ++z) {
      float xr[16], xi[16];
#pragma unroll
      for (int n2 = 0; n2 < 16; ++n2) { xr[n2] = z ? bfhi(ga[n2]) : bflo(ga[n2]); xi[n2] = -(z ? bfhi(gb[n2]) : bflo(gb[n2])); }
#pragma unroll
      for (int bb = 0; bb < 4; ++bb) dft4(xr[bb], xi[bb], xr[4 + bb], xi[4 + bb], xr[8 + bb], xi[8 + bb], xr[12 + bb], xi[12 + bb]);
#pragma unroll
      for (int c = 1; c < 4; ++c)
#pragma unroll
        for (int bb = 1; bb < 4; ++bb) {
          const int m = bb * c;
          const float cw = (m == 1) ? 0.9238795325112867f : (m == 2) ? 0.7071067811865476f : (m == 3) ? 0.3826834323650898f : (m == 4) ? 0.f : (m == 6) ? -0.7071067811865476f : -0.9238795325112867f;
          const float sw = (m == 1) ? 0.3826834323650898f : (m == 2) ? 0.7071067811865476f : (m == 3) ? 0.9238795325112867f : (m == 4) ? 1.f : (m == 6) ? 0.7071067811865476f : -0.3826834323650898f;
          const float a = xr[4 * c + bb], bq = xi[4 * c + bb];
          xr[4 * c + bb] = a * cw + bq * sw; xi[4 * c + bb] = bq * cw - a * sw;
        }
#pragma unroll
      for (int c = 0; c < 4; ++c) dft4(xr[4 * c], xi[4 * c], xr[4 * c + 1], xi[4 * c + 1], xr[4 * c + 2], xi[4 * c + 2], xr[4 * c + 3], xi[4 * c + 3]);
#pragma unroll
      for (int c = 0; c < 4; ++c)
#pragma unroll
        for (int d = 0; d < 4; ++d) {
          const int k2 = c + 4 * d;
          const float f = (float)(k2 * (n1 + z)) * (1.0f / 4096.0f);
          const float cw = __builtin_amdgcn_cosf(f), sw = __builtin_amdgcn_sinf(f);
          const float a = xr[4 * c + d], bq = xi[4 * c + d];
          outr[z][k2] = a * cw + bq * sw; outi[z][k2] = bq * cw - a * sw;
        }
    }
    bf16_t* wr0 = Wt + ((size_t)(b * 16) * 1024 + ch) * 512 + n1;
#pragma unroll
    for (int k2 = 0; k2 < 16; ++k2) {
      bf16_t* wp = wr0 + (size_t)k2 * (1024 * 512);
      *(unsigned*)wp = pk2(outr[0][k2], outr[1][k2]);
      *(unsigned*)(wp + 256) = pk2(outi[0][k2], outi[1][k2]);
    }
  }
}

#define MFMA32(a, b, c) __builtin_amdgcn_mfma_f32_32x32x16_bf16((a), (b), (c), 0, 0, 0)
constexpr int ATT_BUF = 35840, ATT_KC = 9216, ATT_V = 18432;

DI void attn_item(LAS unsigned char* lds, const Params& p, int b, int head, int t0, int kt0, int kt1, float lam, float oscale, const float* subg) {
  int tid = threadIdx.x; asm volatile("" : "+v"(tid));
  const int wid = tid >> 6, lane = tid & 63, r = lane & 31, h = lane >> 5, comp = wid >> 2, wq = wid & 3;
  const bf16_t* Qb = (const bf16_t*)(p.ws + WS_QB); const bf16_t* Kb = (const bf16_t*)(p.ws + WS_KB); const bf16_t* Vt = (const bf16_t*)(p.ws + WS_VT);
  bf16_t* mix = (bf16_t*)(p.ws + WS_MIX);
  const size_t qrow = (size_t)b * TPB + t0 + wq * 32 + r;
  bf16x8 qf[4];
  { const bf16_t* qp = Qb + qrow * 512 + head * 128 + comp * 64 + 8 * h;
#pragma unroll
    for (int s = 0; s < 4; ++s) qf[s] = *(const bf16x8*)(qp + 16 * s); }
  f32x16 o[4];
#pragma unroll
  for (int k = 0; k < 4; ++k)
#pragma unroll
    for (int i = 0; i < 16; ++i) o[k][i] = 0.f;
  float mrun = -1e30f, lrun = 0.f;
  const float sc = 0.125f * 1.4426950408889634f;
  const char* kg = (const char*)Kb + ((size_t)((b * 4 + head) * 2) * TPB) * 128;
  const char* vg = (const char*)Vt + ((size_t)((b * 4 + head) * 128)) * TPB * 2;
  const unsigned koff[2] = {(unsigned)tid * 16u, (unsigned)tid * 16u + (unsigned)(TPB * 128)};
  const unsigned voff[2] = {(unsigned)(tid >> 3) * (unsigned)(TPB * 2) + (unsigned)(tid & 7) * 16u, (unsigned)((tid >> 3) + 64) * (unsigned)(TPB * 2) + (unsigned)(tid & 7) * 16u};
  const unsigned kl = (unsigned)((tid >> 3) * 144 + (tid & 7) * 16);
  const unsigned vl = (unsigned)(ATT_V + (tid >> 3) * 136 + (tid & 7) * 16);
  u32x4 kr[2], vr[2];
#define ATT_LOAD(kt) do { _Pragma("unroll") for (int i = 0; i < 2; ++i) { \
    kr[i] = *(const u32x4*)(kg + (size_t)(kt) * 8192 + koff[i]); \
    vr[i] = *(const u32x4*)(vg + (size_t)(kt) * 128 + voff[i]); } } while (0)
#define ATT_STORE(buf) do { _Pragma("unroll") for (int i = 0; i < 2; ++i) { \
    *(LAS u32x4*)(lds + (buf) * ATT_BUF + i * ATT_KC + kl) = kr[i]; \
    *(LAS u32x2*)(lds + (buf) * ATT_BUF + i * (64 * 136) + vl) = (u32x2){vr[i].x, vr[i].y}; \
    *(LAS u32x2*)(lds + (buf) * ATT_BUF + i * (64 * 136) + vl + 8) = (u32x2){vr[i].z, vr[i].w}; } } while (0)
  ATT_LOAD(kt0);
  ATT_STORE(0);
  __syncthreads();
  int buf = 0;
  for (int kt = kt0; kt < kt1; ++kt) {
    const bool more = (kt + 1 < kt1);
    if (more) ATT_LOAD(kt + 1);
    const LAS unsigned char* ks = lds + buf * ATT_BUF + comp * ATT_KC + r * 144 + h * 16;
    const LAS unsigned char* vs = lds + buf * ATT_BUF + ATT_V + r * 136 + h * 8;
    f32x16 x[2];
#pragma unroll
    for (int kb = 0; kb < 2; ++kb) {
#pragma unroll
      for (int i = 0; i < 16; ++i) x[kb][i] = 0.f;
#pragma unroll
      for (int s = 0; s < 4; ++s) { const bf16x8 a = *(const LAS bf16x8*)(ks + kb * 4608 + s * 32); x[kb] = MFMA32(a, qf[s], x[kb]); }
    }
    float mx = x[0][0];
#pragma unroll
    for (int kb = 0; kb < 2; ++kb)
#pragma unroll
      for (int i = 0; i < 16; ++i) mx = fmaxf(mx, x[kb][i]);
    mx = fmaxf(mx, __shfl_xor(mx, 32));
    const float mxs = mx * sc;
    const bool need = mxs > mrun + 8.0f;
    if (__builtin_amdgcn_ballot_w64(need) != 0ull) {
      const float mnew = need ? mxs : mrun;
      const float alpha = __builtin_amdgcn_exp2f(mrun - mnew);
      mrun = mnew; lrun *= alpha;
#pragma unroll
      for (int k = 0; k < 4; ++k)
#pragma unroll
        for (int i = 0; i < 16; ++i) o[k][i] *= alpha;
    }
    float ps = 0.f;
#pragma unroll
    for (int kb = 0; kb < 2; ++kb)
#pragma unroll
      for (int i = 0; i < 16; ++i) { const float e = __builtin_amdgcn_exp2f(x[kb][i] * sc - mrun); x[kb][i] = e; ps += e; }
    lrun += ps;
#pragma unroll
    for (int kb = 0; kb < 2; ++kb)
#pragma unroll
      for (int s2 = 0; s2 < 2; ++s2) {
        u32x4 pw; pw.x = pk2(x[kb][8 * s2], x[kb][8 * s2 + 1]); pw.y = pk2(x[kb][8 * s2 + 2], x[kb][8 * s2 + 3]);
        pw.z = pk2(x[kb][8 * s2 + 4], x[kb][8 * s2 + 5]); pw.w = pk2(x[kb][8 * s2 + 6], x[kb][8 * s2 + 7]);
        const bf16x8 pb = __builtin_bit_cast(bf16x8, pw);
#pragma unroll
        for (int blk = 0; blk < 4; ++blk) {
          const s16x4 lo = *(const LAS s16x4*)(vs + blk * 4352 + kb * 64 + s2 * 32);
          const s16x4 hi = *(const LAS s16x4*)(vs + blk * 4352 + kb * 64 + s2 * 32 + 16);
          const bf16x8 a = __builtin_shufflevector(lo, hi, 0, 1, 2, 3, 4, 5, 6, 7);
          o[blk] = MFMA32(a, pb, o[blk]);
        }
      }
    if (more) ATT_STORE(buf ^ 1);
    __syncthreads();
    buf ^= 1;
  }
#undef ATT_LOAD
#undef ATT_STORE
  const float ltot = lrun + __shfl_xor(lrun, 32);
  const float inv = 1.0f / ltot;
  LAS float* cmb = (LAS float*)lds;
  if (comp == 1) {
#pragma unroll
    for (int k = 0; k < 4; ++k)
#pragma unroll
      for (int i = 0; i < 16; ++i) cmb[(wq * 64 + k * 16 + i) * 64 + lane] = o[k][i] * inv;
  }
  __syncthreads();
  if (comp == 0) {
    float ss = 0.f;
#pragma unroll
    for (int k = 0; k < 4; ++k)
#pragma unroll
      for (int i = 0; i < 16; ++i) { const float d = o[k][i] * inv - lam * cmb[(wq * 64 + k * 16 + i) * 64 + lane]; o[k][i] = d; ss += d * d; }
    ss += __shfl_xor(ss, 32);
    const float rn = __builtin_amdgcn_rsqf(ss * (1.0f / 128.0f) + 1e-5f) * oscale;
    bf16_t* dst = mix + qrow * 1024 + 512 + head * 128;
#pragma unroll
    for (int k = 0; k < 4; ++k)
#pragma unroll
      for (int g4 = 0; g4 < 4; ++g4) {
        const int dv = 32 * k + 8 * g4 + 4 * h;
        const f32x4 gg = *(const f32x4*)(subg + dv);
        u32x2 w; w.x = pk2(o[k][4 * g4] * rn * gg[0], o[k][4 * g4 + 1] * rn * gg[1]); w.y = pk2(o[k][4 * g4 + 2] * rn * gg[2], o[k][4 * g4 + 3] * rn * gg[3]);
        *(u32x2*)(dst + dv) = w;
      }
  }
  __syncthreads();
}

DI void conv_item(const Params& p, int ci, const float* cw) {
  int tid = threadIdx.x; asm volatile("" : "+v"(tid));
  const int cg8 = tid & 63, rr = tid >> 6, c0 = cg8 * 8;
  const bf16_t* P = (const bf16_t*)(p.ws + WS_P); bf16_t* mix = (bf16_t*)(p.ws + WS_MIX);
  float w0[8], w1[8], w2[8];
#pragma unroll
  for (int e = 0; e < 8; ++e) { w0[e] = cw[c0 + e]; w1[e] = cw[512 + c0 + e]; w2[e] = cw[1024 + c0 + e]; }
#pragma unroll 1
  for (int q = 0; q < 4; ++q) {
    const int r = ci * 32 + rr + 8 * q, t = r % TPB;
    const bf16_t* pr = P + (size_t)r * 1536 + c0;
    const u32x4 gb = *(const u32x4*)pr;
    const u32x4 gc1 = *(const u32x4*)(pr + 512), v1 = *(const u32x4*)(pr + 1024);
    u32x4 gc0 = (u32x4){0, 0, 0, 0}, v0 = gc0, gc2 = gc0, v2 = gc0;
    if (t != 0 && t != 4096) { gc0 = *(const u32x4*)(pr - 1536 + 512); v0 = *(const u32x4*)(pr - 1536 + 1024); }
    if (t != 4095 && t != 4351) { gc2 = *(const u32x4*)(pr + 1536 + 512); v2 = *(const u32x4*)(pr + 1536 + 1024); }
    float o[8];
#pragma unroll
    for (int e2 = 0; e2 < 4; ++e2) {
      const float a0 = bflo(gc0[e2]) * bflo(v0[e2]), a1 = bflo(gc1[e2]) * bflo(v1[e2]), a2 = bflo(gc2[e2]) * bflo(v2[e2]);
      const float b0 = bfhi(gc0[e2]) * bfhi(v0[e2]), b1 = bfhi(gc1[e2]) * bfhi(v1[e2]), b2 = bfhi(gc2[e2]) * bfhi(v2[e2]);
      o[2 * e2] = bflo(gb[e2]) * (w0[2 * e2] * a0 + w1[2 * e2] * a1 + w2[2 * e2] * a2);
      o[2 * e2 + 1] = bfhi(gb[e2]) * (w0[2 * e2 + 1] * b0 + w1[2 * e2 + 1] * b1 + w2[2 * e2 + 1] * b2);
    }
    u32x4 w; w.x = pk2(o[0], o[1]); w.y = pk2(o[2], o[3]); w.z = pk2(o[4], o[5]); w.w = pk2(o[6], o[7]);
    *(u32x4*)(mix + (size_t)r * 1024 + c0) = w;
  }
}

DI void attn_phase(LAS unsigned char* lds, const Params& p, int layer) {
  int tid0 = threadIdx.x; asm volatile("" : "+v"(tid0));
  const int j = layer >> 1, lane = tid0 & 63;
  const float lam_init = (layer == 0) ? 0.2f : 0.47071301834382377f;
  const float* lq = p.lam_qk + j * 256;
  const float sa = wave_sum(lq[lane] * lq[64 + lane]), sb = wave_sum(lq[128 + lane] * lq[192 + lane]);
  const float lam = __builtin_amdgcn_exp2f(sa * 1.4426950408889634f) - __builtin_amdgcn_exp2f(sb * 1.4426950408889634f) + lam_init;
  const float oscale = 1.0f - lam_init;
  const float* subg = p.subln_g + j * 128;
  const float* cw = p.conv_w + j * 1536;
  const int natt = 512 + (layer == 0 ? 32 : 0), total = natt + 544;
  for (int it = blockIdx.x; it < total; it += gridDim.x) {
    if (it < 512) {
      const int round = it >> 8, c = it & 255, pair = round * 8 + (c & 7), qblk = c >> 3;
      attn_item(lds, p, pair >> 2, pair & 3, qblk * 128, 0, 68, lam, oscale, subg);
    } else if (it < natt) {
      const int c = it - 512;
      attn_item(lds, p, c >> 3, (c >> 1) & 3, 4096 + (c & 1) * 128, 64, 68, lam, oscale, subg);
    } else conv_item(p, it - natt, cw);
  }
}

__global__ void __launch_bounds__(512, 2) fwd_megakernel(Params p) {
  extern __shared__ __attribute__((aligned(16))) unsigned char shm[];
  LAS unsigned char* lds = (LAS unsigned char*)shm;
  cg::grid_group grid = cg::this_grid();
  unsigned char* ws = p.ws;
  const float* mod = (const float*)(ws + WS_MOD);
  bf16_t* U = (bf16_t*)(ws + WS_U); bf16_t* Y = (bf16_t*)(ws + WS_Y);

  unsigned* bar = (unsigned*)(ws + WS_BAR);
  volatile LAS unsigned* xst = (volatile LAS unsigned*)(lds + 131072);
  if (blockIdx.x == 0) for (int i = threadIdx.x; i < XCD_BAR_WORDS; i += 512) __hip_atomic_store(&bar[i], 0u, __ATOMIC_RELAXED, __HIP_MEMORY_SCOPE_AGENT);
  if (threadIdx.x == 0) { xst[0] = 0u; xst[1] = 0u; }
  __syncthreads();
  for (int rep = 0; rep < REP_P0; ++rep) { phase0(lds, p); __syncthreads(); }
  grid.sync();
  const XcdBarrier xb = xcd_barrier_post(bar, xst);
#define GSYNC() xcd_barrier(xb)
  phase0b(p);
  GSYNC();
  ln_pass(p, true, nullptr, nullptr, nullptr, mod + 0, mod + 1024, false, false, 0);
  GSYNC();

  bf16_t* PART = (bf16_t*)p.out;
  for (int layer = 0; layer < 4; ++layer) {
    const int j = layer >> 1;
    const float* lmod = mod + (size_t)layer * 30720;
    const bool ctx_alive = layer < 2;
    int nks_mid = 0;
    if ((layer & 1) == 0) {
      { Gemm g{U, (const bf16_t*)(ws + WS_WIN) + (size_t)j * 3145728, NROW, 2560, 1024, 0, 1, 0, 1024, 1024};
        Epi<EP_QKC> e{(bf16_t*)(ws + WS_P), (bf16_t*)(ws + WS_QB), (bf16_t*)(ws + WS_KB), (const float*)(ws + WS_ROPE), (const float*)(ws + WS_ROPE) + 1024, 0, 0, 0};
        for (int rep = 0; rep < REP_GEMM * REP_E1A; ++rep) gemm_phase(lds, g, e); }
      { Gemm g{(const bf16_t*)(ws + WS_WIN) + (size_t)j * 3145728 + (size_t)2560 * 1024, U, 512, NROW, 1024, 0, 1, 0, 1024, 1024};
        Epi<EP_VT> e{(bf16_t*)(ws + WS_VT), nullptr, nullptr, nullptr, nullptr, 0, 0, 0};
        for (int rep = 0; rep < REP_GEMM * REP_E1V; ++rep) gemm_phase(lds, g, e); }
      GSYNC();
      for (int rep = 0; rep < REP_ATT; ++rep) attn_phase(lds, p, layer);
      GSYNC();
      { Gemm g{(const bf16_t*)(ws + WS_MIX), (const bf16_t*)(ws + WS_WOM) + (size_t)j * 1048576, 16384, 1024, 1024, 1, 1, 0, 1024, 1024};
        Epi<EP_PLAIN> e{Y, nullptr, nullptr, nullptr, nullptr, 1024, 0, 0};
        for (int rep = 0; rep < REP_GEMM * REP_E3L; ++rep) gemm_phase(lds, g, e); }
      if (ctx_alive) {
        Gemm g{(const bf16_t*)(ws + WS_MIX), (const bf16_t*)(ws + WS_WOM) + (size_t)j * 1048576, 4096, 1024, 256, 4, 4, 0, 1024, 1024};
        Epi<EP_PLAIN> e{PART, nullptr, nullptr, nullptr, nullptr, 1024, 4, 4};
        for (int rep = 0; rep < REP_GEMM * REP_E3C; ++rep) gemm_phase(lds, g, e);
        nks_mid = 4;
      }
      GSYNC();
    } else {
      { Gemm g{(const bf16_t*)(ws + WS_W12) + (size_t)j * 2097152, U, 2048, ctx_alive ? NROW : 16384, 1024, ctx_alive ? 0 : 2, 1, 0, 1024, 1024};
        Epi<EP_ZT> e{(bf16_t*)(ws + WS_ZT), (bf16_t*)(ws + WS_ZTC), nullptr, nullptr, nullptr, 0, 0, 0};
        for (int rep = 0; rep < REP_GEMM * REP_O1; ++rep) gemm_phase(lds, g, e); }
      GSYNC();
      fft16_pass(p);
      GSYNC();
      { Gemm g{(const bf16_t*)(ws + WS_DN2), (const bf16_t*)(ws + WS_WT), 16384, 1024, 512, 3, 1, (size_t)1024 * 512 * 2, 512, 512};
        Epi<EP_PLAIN> e{Y, nullptr, nullptr, nullptr, nullptr, 1024, 3, 0};
        for (int rep = 0; rep < REP_GEMM * REP_O2L; ++rep) gemm_phase(lds, g, e); }
      if (ctx_alive) {
        Gemm g{(const bf16_t*)(ws + WS_DN256), (const bf16_t*)(ws + WS_ZTC), 1024, 1024, 512, 3, 1, (size_t)1024 * 512 * 2, 512, 512};
        Epi<EP_PLAIN> e{Y, nullptr, nullptr, nullptr, nullptr, 1024, 2, 0};
        for (int rep = 0; rep < REP_GEMM * REP_O2C; ++rep) gemm_phase(lds, g, e);
      }
      GSYNC();
    }
    ln_pass(p, false, lmod + 2048, p.ln_g + (size_t)(layer * 2) * 1024, p.ln_b + (size_t)(layer * 2) * 1024, lmod + 3072, lmod + 4096, false, !ctx_alive, nks_mid);
    GSYNC();
    { Gemm g{U, (const bf16_t*)(ws + WS_W1) + (size_t)layer * 4194304, ctx_alive ? NROW : 16384, 4096, 1024, ctx_alive ? 0 : 1, 1, 0, 1024, 1024};
      Epi<EP_RELU2> e{(bf16_t*)(ws + WS_HID), nullptr, nullptr, nullptr, nullptr, 4096, 0, 0};
      for (int rep = 0; rep < REP_GEMM * REP_M1; ++rep) gemm_phase(lds, g, e); }
    GSYNC();
    { Gemm g{(const bf16_t*)(ws + WS_HID), (const bf16_t*)(ws + WS_W2) + (size_t)layer * 4194304, 16384, 1024, 4096, 1, 1, 0, 4096, 4096};
      Epi<EP_PLAIN> e{Y, nullptr, nullptr, nullptr, nullptr, 1024, 0, 0};
      for (int rep = 0; rep < REP_GEMM * REP_M2L; ++rep) gemm_phase(lds, g, e); }
    if (ctx_alive) {
      Gemm g{(const bf16_t*)(ws + WS_HID), (const bf16_t*)(ws + WS_W2) + (size_t)layer * 4194304, 16384, 1024, 256, 4, 16, 0, 4096, 4096};
      Epi<EP_PLAIN> e{PART, nullptr, nullptr, nullptr, nullptr, 1024, 4, 16};
      for (int rep = 0; rep < REP_GEMM * REP_M2C; ++rep) gemm_phase(lds, g, e);
    }
    GSYNC();
    const bool lat_only_end = layer >= 2;
    const float* nmod = mod + (size_t)(layer + 1) * 30720;
    ln_pass(p, false, lmod + 5120, p.ln_g + (size_t)(layer * 2 + 1) * 1024, p.ln_b + (size_t)(layer * 2 + 1) * 1024, nmod + 0, nmod + 1024, layer == 3, lat_only_end, ctx_alive ? 16 : 0);
    if (layer < 3) { for (int rep = 0; rep < 1 + 10 * (REP_SYNC - 1); ++rep) GSYNC(); }
  }
}

extern "C" void kernel_launch(void* const* d_in, const int* in_sizes, int n_in, void* d_out, int out_size, void* d_ws, size_t ws_size, hipStream_t stream) {
  constexpr size_t kDynLds = 131072 + 256;
  static int grid_blocks = 0;
  if (!grid_blocks) {
    int dev = 0, cus = 0, per_cu = 0;
    (void)hipGetDevice(&dev);
    (void)hipDeviceGetAttribute(&cus, hipDeviceAttributeMultiprocessorCount, dev);
    (void)hipFuncSetAttribute((const void*)fwd_megakernel, hipFuncAttributeMaxDynamicSharedMemorySize, (int)kDynLds);
    (void)hipOccupancyMaxActiveBlocksPerMultiprocessor(&per_cu, (const void*)fwd_megakernel, 512, kDynLds);
    if (per_cu < 1) per_cu = 1;
    if (per_cu > 1) per_cu = 1;
    grid_blocks = cus * per_cu;
    if (ws_size < WS_END) fprintf(stderr, "kernel_launch: workspace too small: %zu < %zu\n", ws_size, (size_t)WS_END);
  }
  Params p{};
  p.x = (const float*)d_in[0]; p.c = (const float*)d_in[1]; p.ctx = (const float*)d_in[2]; p.c_ctx = (const float*)d_in[3];
  p.ada_w = (const float*)d_in[4]; p.ada_b = (const float*)d_in[5]; p.ln_g = (const float*)d_in[6]; p.ln_b = (const float*)d_in[7];
  p.w1 = (const float*)d_in[8]; p.w2 = (const float*)d_in[9]; p.w_in = (const float*)d_in[10]; p.conv_w = (const float*)d_in[11];
  p.lam_qk = (const float*)d_in[12]; p.subln_g = (const float*)d_in[13]; p.w_out_mix = (const float*)d_in[14]; p.w_out_f = (const float*)d_in[15];
  p.out = (float*)d_out; p.ws = (unsigned char*)d_ws;
  void* args[] = {&p};
  hipError_t e = hipLaunchCooperativeKernel((void*)fwd_megakernel, dim3(grid_blocks), dim3(512), args, kDynLds, stream);
  if (e != hipSuccess) fprintf(stderr, "cooperative launch failed: %s (grid %d)\n", hipGetErrorString(e), grid_blocks);
}
```

```cpp
#include <hip/hip_runtime.h>
#include <hip/hip_cooperative_groups.h>
#include <cstdio>
namespace cg = cooperative_groups;
#ifndef REP_P0
#define REP_P0 1
#endif
#ifndef REP_ATT
#define REP_ATT 1
#endif
#ifndef REP_GEMM
#define REP_GEMM 1
#endif
#ifndef REP_E1A
#define REP_E1A 1
#endif
#ifndef REP_E1V
#define REP_E1V 1
#endif
#ifndef REP_E3L
#define REP_E3L 1
#endif
#ifndef REP_E3C
#define REP_E3C 1
#endif
#ifndef REP_O1
#define REP_O1 1
#endif
#ifndef REP_O2L
#define REP_O2L 1
#endif
#ifndef REP_O2C
#define REP_O2C 1
#endif
#ifndef REP_M1
#define REP_M1 1
#endif
#ifndef REP_M2L
#define REP_M2L 1
#endif
#ifndef REP_M2C
#define REP_M2C 1
#endif
#ifndef REP_SYNC
#define REP_SYNC 1
#endif

#define LAS __attribute__((address_space(3)))
#define DI __device__ __forceinline__
typedef unsigned short bf16_t;
typedef short bf16x8 __attribute__((ext_vector_type(8)));
typedef short s16x4 __attribute__((ext_vector_type(4)));
typedef float f32x4 __attribute__((ext_vector_type(4)));
typedef float f32x2 __attribute__((ext_vector_type(2)));
typedef float f32x16 __attribute__((ext_vector_type(16)));
typedef unsigned u32x4 __attribute__((ext_vector_type(4)));
typedef unsigned u32x2 __attribute__((ext_vector_type(2)));
typedef __bf16 bf2_t __attribute__((ext_vector_type(2)));

constexpr int TPB = 4352;
constexpr int NROW = 17408;
constexpr float ALPHA = 1.681792830507429f;

constexpr size_t WS_WIN = 0;
constexpr size_t WS_W1 = WS_WIN + 12582912;
constexpr size_t WS_W2 = WS_W1 + 33554432;
constexpr size_t WS_WOM = WS_W2 + 33554432;
constexpr size_t WS_W12 = WS_WOM + 4194304;
constexpr size_t WS_H = WS_W12 + 8388608;
constexpr size_t WS_U = WS_H + 71303168;
constexpr size_t WS_Y = WS_U + 35651584;
constexpr size_t WS_BIG = WS_Y + 35651584;
constexpr size_t WS_P = WS_BIG;
constexpr size_t WS_QB = WS_BIG + 53477376;
constexpr size_t WS_KB = WS_QB + 17825792;
constexpr size_t WS_VT = WS_KB + 17825792;
constexpr size_t WS_MIX = WS_VT + 17825792;
constexpr size_t WS_HID = WS_BIG;
constexpr size_t WS_ZT = WS_BIG;
constexpr size_t WS_ZTC = WS_BIG + 67108864;
constexpr size_t WS_WT = WS_ZTC + 4194304;
constexpr size_t WS_MODP = WS_BIG + 142606336;
constexpr size_t WS_MOD = WS_MODP + 7864320;
constexpr size_t WS_ROPE = WS_MOD + 491520;
constexpr size_t WS_DN256 = WS_ROPE + 8192;
constexpr size_t WS_BAR = WS_DN256 + 262144;
constexpr size_t WS_DN2 = WS_BAR + 16384;
constexpr size_t WS_END = WS_DN2 + 262144;

struct Params {
  const float *x, *c, *ctx, *c_ctx, *ada_w, *ada_b, *ln_g, *ln_b, *w1, *w2, *w_in, *conv_w, *lam_qk, *subln_g, *w_out_mix, *w_out_f;
  float* out; unsigned char* ws;
};

DI unsigned pk2(float a, float b) { f32x2 v = {a, b}; bf2_t r = __builtin_convertvector(v, bf2_t); return __builtin_bit_cast(unsigned, r); }
DI float bflo(unsigned w) { return __uint_as_float(w << 16); }
DI float bfhi(unsigned w) { return __uint_as_float(w & 0xffff0000u); }
DI float wave_sum(float v) {
#pragma unroll
  for (int o = 32; o >= 1; o >>= 1) v += __shfl_xor(v, o);
  return v;
}


#define XB_TMO      128
#define XB_XCNT(j)  (256  + 64 * (j))
#define XB_XSUB(j)  (1280 + 64 * (j))
#define XB_XGEN(j)  (2304 + 64 * (j))
#define XB_TOP      3328
#define XB_TOPGEN   3392
#define XCD_BAR_WORDS 3456
#define XB_SPIN_CAP (1u << 20)
DI unsigned xb_ld(unsigned* p)              { return __hip_atomic_load(p, __ATOMIC_RELAXED, __HIP_MEMORY_SCOPE_AGENT); }
DI unsigned xb_add(unsigned* p, unsigned v) { return __hip_atomic_fetch_add(p, v, __ATOMIC_RELAXED, __HIP_MEMORY_SCOPE_AGENT); }
DI unsigned xb_xcc_id() { return (unsigned)__builtin_amdgcn_s_getreg((3 << 11) | 20) & 0xFu; }
#define XB_SPIN(cond, bar) do { unsigned _sp = 0; while (cond) { __builtin_amdgcn_s_sleep(1); \
    if ((++_sp & 255u) == 0u) { if (xb_ld(&(bar)[XB_TMO])) break; if (_sp > XB_SPIN_CAP) { atomicAdd(&(bar)[XB_TMO], 1u); break; } } } } while (0)
struct XcdBarrier { unsigned* bar; unsigned x; volatile LAS unsigned* st; };
DI XcdBarrier xcd_barrier_post(unsigned* bar, volatile LAS unsigned* st) {
  XcdBarrier b; b.bar = bar; b.x = xb_xcc_id(); b.st = st;
  if (threadIdx.x == 0) (void)xb_add(&bar[XB_XCNT(b.x)], 1u);
  return b;
}
DI void xcd_barrier_complete(unsigned* bar, unsigned x, unsigned& nloc, unsigned& nx) {
  const unsigned G = gridDim.x * gridDim.y * gridDim.z;
  unsigned sum, cnt, mine, sp = 0u;
  for (;;) {
    sum = 0u; cnt = 0u; mine = 0u;
#pragma unroll
    for (unsigned j = 0; j < 16; ++j) { const unsigned c = xb_ld(&bar[XB_XCNT(j)]); sum += c; cnt += (c > 0u) ? 1u : 0u; mine = (j == x) ? c : mine; }
    if (sum == G) break;
    __builtin_amdgcn_s_sleep(1);
    if ((++sp & 255u) == 0u) { if (xb_ld(&bar[XB_TMO])) break; if (sp > XB_SPIN_CAP) { atomicAdd(&bar[XB_TMO], 1u); break; } }
  }
  nloc = mine > 0u ? mine : 1u; nx = cnt > 0u ? cnt : 1u;
}
DI void xcd_barrier(const XcdBarrier& b) {
  asm volatile("s_waitcnt vmcnt(0)" ::: "memory");
  __syncthreads();
  if (threadIdx.x == 0) {
    unsigned* bar = b.bar;
    __builtin_amdgcn_s_waitcnt(0);
    unsigned nloc = b.st[0], nx = b.st[1];
    if (nloc == 0u) { xcd_barrier_complete(bar, b.x, nloc, nx); b.st[0] = nloc; b.st[1] = nx; }
    const unsigned old = xb_add(&bar[XB_XSUB(b.x)], 1u);
    const unsigned gen = old / nloc;
    if (old + 1u == (gen + 1u) * nloc) {
      __builtin_amdgcn_fence(__ATOMIC_RELEASE, "agent");
      asm volatile("s_waitcnt vmcnt(0)" ::: "memory");
      const unsigned og = xb_add(&bar[XB_TOP], 1u);
      const unsigned tg = og / nx;
      if (og + 1u == (tg + 1u) * nx) xb_add(&bar[XB_TOPGEN], 1u);
      else XB_SPIN(xb_ld(&bar[XB_TOPGEN]) == tg, bar);
      __builtin_amdgcn_fence(__ATOMIC_ACQUIRE, "agent");
      xb_add(&bar[XB_XGEN(b.x)], 1u);
      asm volatile("s_waitcnt vmcnt(0)" ::: "memory");
    } else {
      XB_SPIN(xb_ld(&bar[XB_XGEN(b.x)]) == gen, bar);
      __builtin_amdgcn_fence(__ATOMIC_ACQUIRE, "agent");
      asm volatile("s_waitcnt vmcnt(0)" ::: "memory");
    }
  }
  __syncthreads();
}

constexpr int BM = 256, BK = 64, HALF = 128, HTB = HALF * BK * 2, STAGE_BYTES = 8 * HTB, NXCD = 8, WGM = 8;
DI int lds_byte(int r, int c) { const int st = (r >> 4) * 2 + (c >> 5), rr = r & 15, cc = c & 31, ob = rr * 64 + cc * 2; return st * 1024 + (ob ^ (((ob >> 9) & 1) << 5)); }
DI void stage_rc(int b, int& R, int& C) { const int st = b / 1024, sb = b % 1024, swz = sb ^ (((sb >> 9) & 1) << 5); R = (st >> 1) * 16 + swz / 64; C = (st & 1) * 32 + (swz % 64) / 2; }
DI int perm32(int rho) { const int n = rho >> 4, i = rho & 15; return 8 * (i >> 2) + 4 * n + (i & 3); }

struct Unit { int pm, pn; };
struct Gemm { const bf16_t* A; const bf16_t* Bt; int M, N, K; int mode; int a_mod; size_t bstride; int lda, ldb; };

struct StaticOrder {
  int nM, nN, nwg, G, c;
  DI void init(int M, int N, int G_, int c_) { nM = M / BM; nN = N / BM; nwg = nM * nN; G = G_; c = c_; }
  DI bool next(int i, Unit& u) const {
    const long L = (long)i * G + c; if (L >= nwg) return false;
    int wgid = (int)L; { const int q = nwg / NXCD, r = nwg % NXCD, xcd = wgid % NXCD, off = wgid / NXCD; wgid = (xcd < r ? xcd * (q + 1) : r * (q + 1) + (xcd - r) * q) + off; }
    const int nig = WGM * nN, gid = wgid / nig, fm = gid * WGM, gsz = (nM - fm) < WGM ? (nM - fm) : WGM;
    u.pm = fm + ((wgid % nig) % gsz); u.pn = (wgid % nig) / gsz; return true;
  }
};

DI void unit_ptrs(const Gemm& g, const Unit& v, size_t tstepA, size_t tstepB, const char*& cA, const char*& cB, Unit& real) {
  int pm = v.pm, pn = v.pn, pa = v.pm, pb = v.pn; size_t boff = 0, aoff = 0;
  if (g.mode == 1) { pm = pm + pm / 16; pa = pm; }
  else if (g.mode == 2) { pn = pn + pn / 16; pb = pn; }
  else if (g.mode == 3) { pa = pm % g.a_mod; boff = (size_t)(pm / g.a_mod) * g.bstride; }
  else if (g.mode == 4) { const int bb = pm / g.a_mod, ks = pm % g.a_mod; pa = 0; aoff = ((size_t)(bb * TPB + 4096) * g.lda + (size_t)ks * 256) * 2; boff = (size_t)ks * 512; }
  cA = (const char*)g.A + aoff + (size_t)pa * tstepA; cB = (const char*)g.Bt + boff + (size_t)pb * tstepB; real.pm = pm; real.pn = pn;
}

template <class Epi>
DI void gemm_phase(LAS unsigned char* lds, const Gemm g, const Epi& E) {
  int tid = threadIdx.x; asm volatile("" : "+v"(tid));
  const int wid = __builtin_amdgcn_readfirstlane(tid >> 6), lane = tid & 63, wr = wid >> 2, wc = wid & 3, fr = lane & 15, fq = lane >> 4;
  const int K = g.K, nt = K / BK;
  StaticOrder S; S.init(g.M, g.N, (int)gridDim.x, (int)blockIdx.x);
  unsigned voffA[2], voffB[2];
#pragma unroll
  for (int i = 0; i < 2; ++i) { int R, C; stage_rc(tid * 16 + i * 8192, R, C); const int Rb = Epi::PERM ? ((R & ~31) + perm32(R & 31)) : R;
    voffA[i] = (unsigned)(R * g.lda + C) * 2u; voffB[i] = (unsigned)(Rb * g.ldb + C) * 2u; }
  const size_t kstep = (size_t)(BK * 2);
  const size_t hstepA = (size_t)HALF * g.lda * 2, hstepB = (size_t)HALF * g.ldb * 2;
  const size_t tstepA = 2 * hstepA, tstepB = 2 * hstepB;
  const unsigned ldsw = (unsigned)wid * 1024u;
  const int aoff = lds_byte(wr * 64 + fr, fq * 8), boff = lds_byte(wc * 32 + fr, fq * 8);
#define PG8_SA(b, h) (((b) * 2 + (h)) * HTB)
#define PG8_SB(b, h) ((4 + (b) * 2 + (h)) * HTB)
#define PG8_STAGE(bufoff, gbase, voff) do { _Pragma("unroll") for (int _i = 0; _i < 2; ++_i) \
        __builtin_amdgcn_global_load_lds((const unsigned*)((const char*)(gbase) + (voff)[_i]), (LAS unsigned*)(lds + (bufoff) + ldsw + _i * 8192), 16, 0, 0); } while (0)
#define PG8_LDA(dst, b, h) do { _Pragma("unroll") for (int m = 0; m < 4; ++m) _Pragma("unroll") for (int k = 0; k < 2; ++k) dst[m][k] = *(const LAS bf16x8*)(lds + PG8_SA(b, h) + aoff + m * 2048 + k * 1024); } while (0)
#define PG8_LDB(dst, b, h) do { _Pragma("unroll") for (int n = 0; n < 2; ++n) _Pragma("unroll") for (int k = 0; k < 2; ++k) dst[n][k] = *(const LAS bf16x8*)(lds + PG8_SB(b, h) + boff + n * 2048 + k * 1024); } while (0)
#define PG8_MMA(ai, bj, At, Bt) do { __builtin_amdgcn_s_setprio(1); _Pragma("unroll") for (int m = 0; m < 4; ++m) _Pragma("unroll") for (int n = 0; n < 2; ++n) _Pragma("unroll") for (int k = 0; k < 2; ++k) \
        acc[ai][bj][m][n] = __builtin_amdgcn_mfma_f32_16x16x32_bf16(Bt[n][k], At[m][k], acc[ai][bj][m][n], 0, 0, 0); __builtin_amdgcn_s_setprio(0); } while (0)
#define PG8_WAIT_V(n) asm volatile("s_waitcnt vmcnt(" #n ")" ::: "memory")
#define PG8_WAIT_L(n) asm volatile("s_waitcnt lgkmcnt(" #n ")" ::: "memory")
#define PG8_BAR __builtin_amdgcn_s_barrier()
#define PG8_SCHED __builtin_amdgcn_sched_barrier(0)
  Unit cur, nxt, curR, nxtR; int ui = 0;
  if (!S.next(0, cur)) return;
  f32x4 acc[2][2][4][2];
#pragma unroll
  for (int a = 0; a < 2; ++a)
#pragma unroll
    for (int b = 0; b < 2; ++b)
#pragma unroll
      for (int m = 0; m < 4; ++m)
#pragma unroll
        for (int n = 0; n < 2; ++n) acc[a][b][m][n] = (f32x4){0.f, 0.f, 0.f, 0.f};
  bf16x8 At[4][2], B0[2][2], B1[2][2];
  const char* cA; const char* cB;
  unit_ptrs(g, cur, tstepA, tstepB, cA, cB, curR);
  PG8_STAGE(PG8_SB(0, 0), cB, voffB); PG8_STAGE(PG8_SA(0, 0), cA, voffA); PG8_STAGE(PG8_SB(0, 1), cB + hstepB, voffB); PG8_STAGE(PG8_SA(0, 1), cA + hstepA, voffA);
  if (wr == 1) PG8_BAR;
  PG8_WAIT_V(4); PG8_BAR;
  PG8_STAGE(PG8_SB(1, 0), cB + kstep, voffB); PG8_STAGE(PG8_SA(1, 0), cA + kstep, voffA); PG8_STAGE(PG8_SB(1, 1), cB + hstepB + kstep, voffB);
  PG8_WAIT_V(6); PG8_BAR;
  for (;;) {
    const bool has_next = S.next(ui + 1, nxt);
    const char* nA = cA; const char* nB = cB; nxtR = curR;
    if (has_next) unit_ptrs(g, nxt, tstepA, tstepB, nA, nB, nxtR);
    for (int t = 0; t < nt; t += 2) {
      const bool last = (t == nt - 2);
      const char* a1 = cA + (size_t)(t + 1) * kstep;
      const char* a2 = last ? nA : cA + (size_t)(t + 2) * kstep; const char* b2 = last ? nB : cB + (size_t)(t + 2) * kstep;
      const char* a3 = a2 + kstep; const char* b3 = b2 + kstep;
      PG8_LDB(B0, 0, 0); PG8_SCHED; PG8_LDA(At, 0, 0); PG8_STAGE(PG8_SA(1, 1), a1 + hstepA, voffA);
      PG8_WAIT_L(8); PG8_BAR; PG8_WAIT_L(0); PG8_MMA(0, 0, At, B0); PG8_BAR; PG8_SCHED;
      PG8_LDB(B1, 0, 1); PG8_STAGE(PG8_SB(0, 0), b2, voffB);
      PG8_BAR; PG8_WAIT_L(0); PG8_MMA(0, 1, At, B1); PG8_BAR;
      PG8_LDA(At, 0, 1); PG8_STAGE(PG8_SA(0, 0), a2, voffA);
      PG8_BAR; PG8_WAIT_L(0); PG8_MMA(1, 0, At, B0); PG8_BAR; PG8_SCHED;
      PG8_STAGE(PG8_SB(0, 1), b2 + hstepB, voffB);
      PG8_WAIT_V(6); PG8_BAR; PG8_MMA(1, 1, At, B1); PG8_BAR;
      PG8_LDB(B0, 1, 0); PG8_SCHED; PG8_LDA(At, 1, 0); PG8_STAGE(PG8_SA(0, 1), a2 + hstepA, voffA);
      PG8_WAIT_L(8); PG8_BAR; PG8_WAIT_L(0); PG8_MMA(0, 0, At, B0); PG8_BAR; PG8_SCHED;
      PG8_LDB(B1, 1, 1); PG8_STAGE(PG8_SB(1, 0), b3, voffB);
      PG8_BAR; PG8_WAIT_L(0); PG8_MMA(0, 1, At, B1); PG8_BAR;
      PG8_LDA(At, 1, 1); PG8_STAGE(PG8_SA(1, 0), a3, voffA);
      PG8_BAR; PG8_WAIT_L(0); PG8_MMA(1, 0, At, B0); PG8_BAR; PG8_SCHED;
      PG8_STAGE(PG8_SB(1, 1), b3 + hstepB, voffB);
      PG8_WAIT_V(6); PG8_BAR; PG8_MMA(1, 1, At, B1); PG8_BAR;
    }
    E(acc, curR, wr, wc, fr, fq);
    if (!has_next) break;
#pragma unroll
    for (int a = 0; a < 2; ++a)
#pragma unroll
      for (int b = 0; b < 2; ++b)
#pragma unroll
        for (int m = 0; m < 4; ++m)
#pragma unroll
          for (int n = 0; n < 2; ++n) acc[a][b][m][n] = (f32x4){0.f, 0.f, 0.f, 0.f};
    cur = nxt; curR = nxtR; cA = nA; cB = nB; ++ui;
  }
  PG8_WAIT_V(0);
  if (wr == 0) PG8_BAR;
  PG8_BAR;
#undef PG8_SA
#undef PG8_SB
#undef PG8_STAGE
#undef PG8_LDA
#undef PG8_LDB
#undef PG8_MMA
#undef PG8_WAIT_V
#undef PG8_WAIT_L
#undef PG8_BAR
#undef PG8_SCHED
}

DI void store8(bf16_t* dst, const f32x4& a, const f32x4& b) {
  u32x4 w; w.x = pk2(a[0], a[1]); w.y = pk2(a[2], a[3]); w.z = pk2(b[0], b[1]); w.w = pk2(b[2], b[3]);
  *(u32x4*)dst = w;
}
enum { EP_PLAIN = 0, EP_RELU2 = 1, EP_QKC = 2, EP_VT = 3, EP_ZT = 4 };
template <int MODE> struct Epi {
  static constexpr bool PERM = true;
  bf16_t* O; bf16_t* O2; bf16_t* O3; const float* ropec; const float* ropes; int ldc; int rowmap; int aux;
  DI void operator()(const f32x4 (&acc)[2][2][4][2], const Unit& u, int wr, int wc, int fr, int fq) const {
    if constexpr (MODE == EP_PLAIN || MODE == EP_RELU2) {
      int rowbase = u.pm * 256;
      if (rowmap == 1) rowbase = (u.pm / 16) * TPB + (u.pm % 16) * 256;
      else if (rowmap == 2) rowbase = u.pm * TPB + 4096;
      const int rmul = (rowmap == 3) ? 16 : 1;
      if (rowmap == 3) rowbase = (u.pm / 16) * TPB + (u.pm % 16);
      if (rowmap == 4) rowbase = (u.pm % aux) * 1024 + (u.pm / aux) * 256;
#pragma unroll
      for (int ai = 0; ai < 2; ++ai)
#pragma unroll
        for (int m = 0; m < 4; ++m) {
          const size_t row = (size_t)(rowbase + rmul * (ai * 128 + wr * 64 + m * 16 + fr));
#pragma unroll
          for (int bj = 0; bj < 2; ++bj) {
            const int col = u.pn * 256 + bj * 128 + wc * 32 + 8 * fq;
            f32x4 v0 = acc[ai][bj][m][0], v1 = acc[ai][bj][m][1];
            if constexpr (MODE == EP_RELU2) {
#pragma unroll
              for (int e = 0; e < 4; ++e) { float a = fmaxf(v0[e], 0.f), b = fmaxf(v1[e], 0.f); v0[e] = a * a; v1[e] = b * b; }
            }
            store8(O + row * ldc + col, v0, v1);
          }
        }
    } else if constexpr (MODE == EP_QKC) {
      const int pn = u.pn, b = u.pm / 17, pmr = u.pm % 17; const bool latent = pmr < 16;
#pragma unroll
      for (int ai = 0; ai < 2; ++ai)
#pragma unroll
        for (int m = 0; m < 4; ++m) {
          const int t = pmr * 256 + ai * 128 + wr * 64 + m * 16 + fr;
          const size_t row = (size_t)b * TPB + t;
#pragma unroll
          for (int bj = 0; bj < 2; ++bj) {
            const int col = pn * 256 + bj * 128 + wc * 32 + 8 * fq;
            f32x4 v0 = acc[ai][bj][m][0], v1 = acc[ai][bj][m][1];
            if (pn < 6) { store8(O + row * 1536 + col, v0, v1); }
            else {
              if (latent) {
                const int pos = (wc & 1) ? (t & 63) : (t >> 6);
                const float* cp = ropec + pos * 16 + 8 * (fq & 1); const float* sp = ropes + pos * 16 + 8 * (fq & 1);
                const f32x4 c0 = *(const f32x4*)cp, c1 = *(const f32x4*)(cp + 4), s0 = *(const f32x4*)sp, s1 = *(const f32x4*)(sp + 4);
                const float sgn = (fq < 2) ? -1.f : 1.f;
#pragma unroll
                for (int e = 0; e < 4; ++e) {
                  const float p0 = __shfl_xor(v0[e], 32), p1 = __shfl_xor(v1[e], 32);
                  v0[e] = v0[e] * c0[e] + sgn * p0 * s0[e];
                  v1[e] = v1[e] * c1[e] + sgn * p1 * s1[e];
                }
              }
              if (pn < 8) { store8(O2 + row * 512 + (col - 1536), v0, v1); }
              else {
                const int head = (pn - 8) * 2 + bj, comp = wc >> 1, d0 = (wc & 1) * 32 + 8 * fq;
                store8(O3 + ((size_t)((b * 4 + head) * 2 + comp) * TPB + t) * 64 + d0, v0, v1);
              }
            }
          }
        }
    } else if constexpr (MODE == EP_VT) {
      const int b = u.pn / 17, pnr = u.pn % 17;
#pragma unroll
      for (int ai = 0; ai < 2; ++ai)
#pragma unroll
        for (int m = 0; m < 4; ++m) {
          const int n = u.pm * 256 + ai * 128 + wr * 64 + m * 16 + fr; const int head = n >> 7, dv = n & 127;
#pragma unroll
          for (int bj = 0; bj < 2; ++bj) {
            const int t = pnr * 256 + bj * 128 + wc * 32 + 8 * fq;
            store8(O + ((size_t)((b * 4 + head) * 128 + dv)) * TPB + t, acc[ai][bj][m][0], acc[ai][bj][m][1]);
          }
        }
    } else {
      const int b = u.pn / 17, pnr = u.pn % 17;
#pragma unroll
      for (int ai = 0; ai < 2; ++ai)
#pragma unroll
        for (int m = 0; m < 4; ++m) {
          const int n = u.pm * 256 + ai * 128 + wr * 64 + m * 16 + fr; const int part = n >> 10, ch = n & 1023;
#pragma unroll
          for (int bj = 0; bj < 2; ++bj) {
            const int tt = pnr * 256 + bj * 128 + wc * 32 + 8 * fq;
            bf16_t* dst = (pnr < 16) ? O + ((size_t)(b * 1024 + ch)) * 8192 + part * 4096 + tt
                                     : O2 + ((size_t)(b * 1024 + ch)) * 512 + part * 256 + (tt - 4096);
            store8(dst, acc[ai][bj][m][0], acc[ai][bj][m][1]);
          }
        }
    }
  }
};

DI void tr_item(LAS float* tile, const float* src, bf16_t* dst, int K, int N, int tk, int tn) {
  const int tid = threadIdx.x;
  f32x4 v[8];
#pragma unroll
  for (int i = 0; i < 8; ++i) { const int idx = tid + 512 * i, k = idx >> 6, n4 = (idx & 63) * 4; v[i] = *(const f32x4*)(src + (size_t)(tk * 64 + k) * N + tn * 256 + n4); }
#pragma unroll
  for (int i = 0; i < 8; ++i) { const int idx = tid + 512 * i, k = idx >> 6, n4 = (idx & 63) * 4;
    tile[k * 257 + n4 + 0] = v[i][0]; tile[k * 257 + n4 + 1] = v[i][1]; tile[k * 257 + n4 + 2] = v[i][2]; tile[k * 257 + n4 + 3] = v[i][3]; }
  __syncthreads();
#pragma unroll
  for (int i = 0; i < 4; ++i) {
    const int jx = tid + 512 * i, n = jx >> 3, k0 = (jx & 7) * 8;
    float e[8];
#pragma unroll
    for (int q = 0; q < 8; ++q) e[q] = tile[(k0 + q) * 257 + n];
    u32x4 w; w.x = pk2(e[0], e[1]); w.y = pk2(e[2], e[3]); w.z = pk2(e[4], e[5]); w.w = pk2(e[6], e[7]);
    *(u32x4*)(dst + (size_t)(tn * 256 + n) * K + tk * 64 + k0) = w;
  }
  __syncthreads();
}

DI void w12_item(LAS float* trig, const Params& p, int it) {
  const int tid = threadIdx.x;
  const int nh = it & 1, part = (it >> 1) & 1, co = (it >> 2) & 15, g = (it >> 6) & 7, j = it >> 9;
  if (tid < 128) { const float f = (float)tid * (1.0f / 128.0f); trig[tid] = __builtin_amdgcn_cosf(f); trig[128 + tid] = __builtin_amdgcn_sinf(f); }
  __syncthreads();
  const int n = nh * 512 + tid, c0 = co * 8;
  const float* W = p.w_out_f + (size_t)j * 1048576 + (size_t)(g * 128) * 1024 + n;
  float acc[8];
#pragma unroll
  for (int e = 0; e < 8; ++e) acc[e] = 0.f;
  for (int kc = 0; kc < 128; ++kc) {
    const float w = W[(size_t)kc * 1024];
#pragma unroll
    for (int e = 0; e < 8; ++e) acc[e] += w * trig[part * 128 + (((c0 + e) * kc) & 127)];
  }
  const float sc = 0.08838834764831845f;
  u32x4 o; o.x = pk2(acc[0] * sc, acc[1] * sc); o.y = pk2(acc[2] * sc, acc[3] * sc); o.z = pk2(acc[4] * sc, acc[5] * sc); o.w = pk2(acc[6] * sc, acc[7] * sc);
  bf16_t* dst = (bf16_t*)(p.ws + WS_W12) + (size_t)j * 2097152 + (size_t)(part * 1024 + n) * 1024 + g * 128 + c0;
  *(u32x4*)dst = o;
  __syncthreads();
}

DI void dn256_item(bf16_t* Dn, int it, float sgn, float scale) {
  const int idx0 = it * 512 + threadIdx.x, k = idx0 >> 6, col0 = (idx0 & 63) * 8, half = col0 >> 8, n0 = col0 & 255;
  float v[8];
#pragma unroll
  for (int e = 0; e < 8; ++e) {
    const int idx = (k * (n0 + e)) & 255; const float f = (float)idx * (1.0f / 256.0f);
    v[e] = (half ? sgn * __builtin_amdgcn_sinf(f) : __builtin_amdgcn_cosf(f)) * scale;
  }
  u32x4 o; o.x = pk2(v[0], v[1]); o.y = pk2(v[2], v[3]); o.z = pk2(v[4], v[5]); o.w = pk2(v[6], v[7]);
  *(u32x4*)(Dn + (size_t)k * 512 + col0) = o;
}
DI void rope_item(float* tab) {
#pragma unroll
  for (int i = 0; i < 2; ++i) {
    const int e = threadIdx.x + 512 * i, pos = e >> 4, fi = e & 15;
    const float inv = __builtin_amdgcn_exp2f(-(float)fi * (13.287712379549449f / 16.0f));
    const float ang = (float)pos * inv; float rev = ang * 0.15915494309189535f; rev = rev - floorf(rev);
    tab[e] = __builtin_amdgcn_cosf(rev); tab[1024 + e] = __builtin_amdgcn_sinf(rev);
  }
}
DI void modp_item(LAS float* sm, const Params& p, int it) {
  const int tid = threadIdx.x, layer = it / 96, rem = it % 96, cb = rem / 16, kc = rem % 16;
  LAS float* scv = sm;
  LAS float* red = sm + 320;
  if (tid < 320) { const int cond = tid >> 6, kk = tid & 63, k = kc * 64 + kk; const float v = cond < 4 ? p.c[cond * 1024 + k] : p.c_ctx[k];
    scv[tid] = v / (1.0f + __builtin_amdgcn_exp2f(-v * 1.4426950408889634f)); }
  __syncthreads();
  const int c4 = tid & 255, kh = tid >> 8;
  f32x4 acc[5];
#pragma unroll
  for (int cnd = 0; cnd < 5; ++cnd) acc[cnd] = (f32x4){0.f, 0.f, 0.f, 0.f};
  const float* wp = p.ada_w + ((size_t)layer * 1024 + kc * 64 + kh * 32) * 6144 + cb * 1024 + c4 * 4;
  for (int kk = 0; kk < 32; ++kk) {
    const f32x4 w = *(const f32x4*)(wp + (size_t)kk * 6144);
#pragma unroll
    for (int cnd = 0; cnd < 5; ++cnd) acc[cnd] += w * scv[cnd * 64 + kh * 32 + kk];
  }
  if (kh == 1) {
#pragma unroll
    for (int cnd = 0; cnd < 5; ++cnd) *(LAS f32x4*)(red + (cnd * 256 + c4) * 4) = acc[cnd];
  }
  __syncthreads();
  if (kh == 0) {
    float* mp = (float*)(p.ws + WS_MODP);
#pragma unroll
    for (int cnd = 0; cnd < 5; ++cnd) {
      const f32x4 o = acc[cnd] + *(const LAS f32x4*)(red + (cnd * 256 + c4) * 4);
      *(f32x4*)(mp + ((size_t)((kc * 4 + layer) * 5 + cnd)) * 6144 + cb * 1024 + c4 * 4) = o;
    }
  }
  __syncthreads();
}

DI void phase0(LAS unsigned char* lds, const Params& p) {
  LAS float* smf = (LAS float*)lds;
  constexpr int N_TR = 2560, N_W12 = 1024, N_DN = 32, N_D256 = 32, N_ROPE = 1, N_MODP = 384;
  constexpr int TOT = N_TR + N_W12 + N_DN + N_D256 + N_ROPE + N_MODP;
  for (int it = blockIdx.x; it < TOT; it += gridDim.x) {
    int i = it;
    if (i < N_MODP) { modp_item(smf, p, i); continue; }
    i -= N_MODP;
    if (i < N_W12) { w12_item(smf, p, i); continue; }
    i -= N_W12;
    if (i < N_TR) {
      if (i < 384) { const int j = i / 192, rem = i % 192; tr_item(smf, p.w_in + (size_t)j * 3145728, (bf16_t*)(p.ws + WS_WIN) + (size_t)j * 3145728, 1024, 3072, rem / 12, rem % 12); }
      else if (i < 1408) { const int q = i - 384, l = q / 256, rem = q % 256; tr_item(smf, p.w1 + (size_t)l * 4194304, (bf16_t*)(p.ws + WS_W1) + (size_t)l * 4194304, 1024, 4096, rem / 16, rem % 16); }
      else if (i < 2432) { const int q = i - 1408, l = q / 256, rem = q % 256; tr_item(smf, p.w2 + (size_t)l * 4194304, (bf16_t*)(p.ws + WS_W2) + (size_t)l * 4194304, 4096, 1024, rem / 4, rem % 4); }
      else { const int q = i - 2432, j = q / 64, rem = q % 64; tr_item(smf, p.w_out_mix + (size_t)j * 1048576, (bf16_t*)(p.ws + WS_WOM) + (size_t)j * 1048576, 1024, 1024, rem / 4, rem % 4); }
      continue;
    }
    i -= N_TR;
    if (i < N_DN) { dn256_item((bf16_t*)(p.ws + WS_DN2), i, 1.0f, 1.0f / 64.0f); continue; }
    i -= N_DN;
    if (i < N_D256) { dn256_item((bf16_t*)(p.ws + WS_DN256), i, -1.0f, 1.0f / 16.0f); continue; }
    rope_item((float*)(p.ws + WS_ROPE));
  }
}

DI void phase0b(const Params& p) {
  const float* mp = (const float*)(p.ws + WS_MODP); float* mod = (float*)(p.ws + WS_MOD);
  for (int i = blockIdx.x * 512 + threadIdx.x; i < 30720; i += gridDim.x * 512) {
    const int e = i * 4, layer = e / 30720, col = e % 6144;
    f32x4 a = *(const f32x4*)(p.ada_b + layer * 6144 + col);
#pragma unroll
    for (int kc = 0; kc < 16; ++kc) a += *(const f32x4*)(mp + (size_t)kc * 122880 + e);
    *(f32x4*)(mod + e) = a;
  }
}

DI void ln_pass(const Params& p, bool first, const float* gate, const float* lng, const float* lnb, const float* nsh, const float* nsc, bool last, bool lat_only, int nks) {
  int tid = threadIdx.x; asm volatile("" : "+v"(tid));
  const int wave = tid >> 6, lane = tid & 63;
  float* H = (float*)(p.ws + WS_H); const bf16_t* Y = (const bf16_t*)(p.ws + WS_Y); bf16_t* U = (bf16_t*)(p.ws + WS_U);
  const int npairs = (lat_only ? 16384 : NROW) / 2;
  for (int pi = blockIdx.x * 8 + wave; pi < npairs; pi += gridDim.x * 8) {
    const int rv = pi * 2;
    int b, t;
    if (lat_only) { b = rv >> 12; t = rv & 4095; } else { b = rv / TPB; t = rv % TPB; }
    const size_t r = (size_t)b * TPB + t; const int cond = t < 4096 ? b : 4;
    float v[2][16];
    if (first) {
      const float* src = t < 4096 ? p.x + ((size_t)(b * 4096 + t)) * 1024 : p.ctx + ((size_t)(b * 256 + t - 4096)) * 1024;
#pragma unroll
      for (int z = 0; z < 2; ++z)
#pragma unroll
        for (int q = 0; q < 4; ++q) { const f32x4 a = *(const f32x4*)(src + z * 1024 + q * 256 + lane * 4); v[z][4 * q] = a[0]; v[z][4 * q + 1] = a[1]; v[z][4 * q + 2] = a[2]; v[z][4 * q + 3] = a[3]; }
    } else {
      const float* hr = H + r * 1024; const bf16_t* yr = Y + r * 1024; const float* gr = gate + cond * 6144;
      f32x4 ha[2][4]; f32x4 yv[2][4];
#pragma unroll
      for (int z = 0; z < 2; ++z)
#pragma unroll
        for (int q = 0; q < 4; ++q) { const int c = z * 1024 + q * 256 + lane * 4; ha[z][q] = *(const f32x4*)(hr + c); }
      if (nks > 0 && t >= 4096) {
        const bf16_t* pr = (const bf16_t*)p.out + ((size_t)(b * 256 + t - 4096)) * 1024;
#pragma unroll
        for (int z = 0; z < 2; ++z)
#pragma unroll
          for (int q = 0; q < 4; ++q) yv[z][q] = (f32x4){0.f, 0.f, 0.f, 0.f};
        for (int ks = 0; ks < nks; ++ks) {
#pragma unroll
          for (int z = 0; z < 2; ++z)
#pragma unroll
            for (int q = 0; q < 4; ++q) { const u32x2 w = *(const u32x2*)(pr + (size_t)ks * 1048576 + z * 1024 + q * 256 + lane * 4);
              yv[z][q][0] += bflo(w.x); yv[z][q][1] += bfhi(w.x); yv[z][q][2] += bflo(w.y); yv[z][q][3] += bfhi(w.y); }
        }
      } else {
#pragma unroll
        for (int z = 0; z < 2; ++z)
#pragma unroll
          for (int q = 0; q < 4; ++q) { const u32x2 w = *(const u32x2*)(yr + z * 1024 + q * 256 + lane * 4); yv[z][q] = (f32x4){bflo(w.x), bfhi(w.x), bflo(w.y), bfhi(w.y)}; }
      }
      float s[2] = {0.f, 0.f};
#pragma unroll
      for (int q = 0; q < 4; ++q) {
        const f32x4 g = *(const f32x4*)(gr + q * 256 + lane * 4);
#pragma unroll
        for (int z = 0; z < 2; ++z) {
#pragma unroll
          for (int e = 0; e < 4; ++e) v[z][4 * q + e] = ALPHA * ha[z][q][e] + g[e] * yv[z][q][e];
          s[z] += v[z][4 * q] + v[z][4 * q + 1] + v[z][4 * q + 2] + v[z][4 * q + 3];
        }
      }
      float mu[2], rstd[2];
#pragma unroll
      for (int z = 0; z < 2; ++z) mu[z] = wave_sum(s[z]) * (1.0f / 1024.0f);
#pragma unroll
      for (int z = 0; z < 2; ++z) { float ss = 0.f;
#pragma unroll
        for (int e = 0; e < 16; ++e) { const float d = v[z][e] - mu[z]; ss += d * d; }
        s[z] = ss; }
#pragma unroll
      for (int z = 0; z < 2; ++z) rstd[z] = __builtin_amdgcn_rsqf(wave_sum(s[z]) * (1.0f / 1024.0f) + 1e-6f);
#pragma unroll
      for (int q = 0; q < 4; ++q) {
        const int c = q * 256 + lane * 4;
        const f32x4 g = *(const f32x4*)(lng + c), bb = *(const f32x4*)(lnb + c);
#pragma unroll
        for (int z = 0; z < 2; ++z)
#pragma unroll
          for (int e = 0; e < 4; ++e) v[z][4 * q + e] = (v[z][4 * q + e] - mu[z]) * rstd[z] * g[e] + bb[e];
      }
    }
    float* dst = last ? p.out + ((size_t)(b * 4096 + t)) * 1024 : H + r * 1024;
#pragma unroll
    for (int z = 0; z < 2; ++z)
#pragma unroll
      for (int q = 0; q < 4; ++q) *(f32x4*)(dst + z * 1024 + q * 256 + lane * 4) = (f32x4){v[z][4 * q], v[z][4 * q + 1], v[z][4 * q + 2], v[z][4 * q + 3]};
    if (!last) {
      float s[2], mu[2], rstd[2];
#pragma unroll
      for (int z = 0; z < 2; ++z) { float a = 0.f;
#pragma unroll
        for (int e = 0; e < 16; ++e) a += v[z][e];
        s[z] = a; }
#pragma unroll
      for (int z = 0; z < 2; ++z) mu[z] = wave_sum(s[z]) * (1.0f / 1024.0f);
#pragma unroll
      for (int z = 0; z < 2; ++z) { float ss = 0.f;
#pragma unroll
        for (int e = 0; e < 16; ++e) { const float d = v[z][e] - mu[z]; ss += d * d; }
        s[z] = ss; }
#pragma unroll
      for (int z = 0; z < 2; ++z) rstd[z] = __builtin_amdgcn_rsqf(wave_sum(s[z]) * (1.0f / 1024.0f) + 1e-6f);
      const float* shr = nsh + cond * 6144; const float* scr = nsc + cond * 6144;
#pragma unroll
      for (int q = 0; q < 4; ++q) {
        const int c = q * 256 + lane * 4;
        const f32x4 sh = *(const f32x4*)(shr + c), sc = *(const f32x4*)(scr + c);
#pragma unroll
        for (int z = 0; z < 2; ++z) {
          float o[4];
#pragma unroll
          for (int e = 0; e < 4; ++e) o[e] = (v[z][4 * q + e] - mu[z]) * rstd[z] * (1.0f + sc[e]) + sh[e];
          u32x2 w; w.x = pk2(o[0], o[1]); w.y = pk2(o[2], o[3]);
          *(u32x2*)(U + (r + z) * 1024 + c) = w;
        }
      }
    }
  }
}


DI void dft4(float& r0, float& i0, float& r1, float& i1, float& r2, float& i2, float& r3, float& i3) {
  const float t0r = r0 + r2, t0i = i0 + i2, t1r = r0 - r2, t1i = i0 - i2, t2r = r1 + r3, t2i = i1 + i3, t3r = r1 - r3, t3i = i1 - i3;
  r0 = t0r + t2r; i0 = t0i + t2i; r2 = t0r - t2r; i2 = t0i - t2i;
  r1 = t1r + t3i; i1 = t1i - t3r; r3 = t1r - t3i; i3 = t1i + t3r;
}
DI void fft16_pass(const Params& p) {
  int tid = threadIdx.x; asm volatile("" : "+v"(tid));
  const bf16_t* Zt = (const bf16_t*)(p.ws + WS_ZT); bf16_t* Wt = (bf16_t*)(p.ws + WS_WT);
  const int sub = tid >> 7, np = tid & 127, n1 = np * 2;
  for (int it = blockIdx.x; it < 1024; it += gridDim.x) {
    const int bc = it * 4 + sub, b = bc >> 10, ch = bc & 1023;
    const bf16_t* zr = Zt + (size_t)bc * 8192 + n1;
    unsigned ga[16], gb[16];
#pragma unroll
    for (int n2 = 0; n2 < 16; ++n2) { ga[n2] = *(const unsigned*)(zr + 256 * n2); gb[n2] = *(const unsigned*)(zr + 4096 + 256 * n2); }
    float outr[2][16], outi[2][16];
#pragma unroll
    for (int z = 0; z < 2; ++z) {
      float xr[16], xi[16];
#pragma unroll
      for (int n2 = 0; n2 < 16; ++n2) { xr[n2] = z ? bfhi(ga[n2]) : bflo(ga[n2]); xi[n2] = -(z ? bfhi(gb[n2]) : bflo(gb[n2])); }
#pragma unroll
      for (int bb = 0; bb < 4; ++bb) dft4(xr[bb], xi[bb], xr[4 + bb], xi[4 + bb], xr[8 + bb], xi[8 + bb], xr[12 + bb], xi[12 + bb]);
#pragma unroll
      for (int c = 1; c < 4; ++c)
#pragma unroll
        for (int bb = 1; bb < 4; ++bb) {
          const int m = bb * c;
          const float cw = (m == 1) ? 0.9238795325112867f : (m == 2) ? 0.7071067811865476f : (m == 3) ? 0.3826834323650898f : (m == 4) ? 0.f : (m == 6) ? -0.7071067811865476f : -0.9238795325112867f;
          const float sw = (m == 1) ? 0.3826834323650898f : (m == 2) ? 0.7071067811865476f : (m == 3) ? 0.9238795325112867f : (m == 4) ? 1.f : (m == 6) ? 0.7071067811865476f : -0.3826834323650898f;
          const float a = xr[4 * c + bb], bq = xi[4 * c + bb];
          xr[4 * c + bb] = a * cw + bq * sw; xi[4 * c + bb] = bq * cw - a * sw;
        }
#pragma unroll
      for (int c = 0; c < 4; ++c) dft4(xr[4 * c], xi[4 * c], xr[4 * c + 1], xi[4 * c + 1], xr[4 * c + 2], xi[4 * c + 2], xr[4 * c + 3], xi[4 * c + 3]);
#pragma unroll
      for (int c = 0; c < 4; ++c)
#pragma unroll
        for (int d = 0; d < 4; ++d) {
          const int k2 = c + 4 * d;
          const float f = (float)(k2 * (n1 + z)) * (1.0f / 4096.0f);
          const float cw = __builtin_amdgcn_cosf(f), sw = __builtin_amdgcn_sinf(f);
          const float a = xr[4 * c + d], bq = xi[4 * c + d];
          outr[z][k2] = a * cw + bq * sw; outi[z][k2] = bq * cw - a * sw;
        }
    }
    bf16_t* wr0 = Wt + ((size_t)(b * 16) * 1024 + ch) * 512 + n1;
#pragma unroll
    for (int k2 = 0; k2 < 16; ++k2) {
      bf16_t* wp = wr0 + (size_t)k2 * (1024 * 512);
      *(unsigned*)wp = pk2(outr[0][k2], outr[1][k2]);
      *(unsigned*)(wp + 256) = pk2(outi[0][k2], outi[1][k2]);
    }
  }
}

#define MFMA32(a, b, c) __builtin_amdgcn_mfma_f32_32x32x16_bf16((a), (b), (c), 0, 0, 0)
constexpr int ATT_BUF = 35840, ATT_KC = 9216, ATT_V = 18432;

DI void attn_item(LAS unsigned char* lds, const Params& p, int b, int head, int t0, int kt0, int kt1, float lam, float oscale, const float* subg) {
  int tid = threadIdx.x; asm volatile("" : "+v"(tid));
  const int wid = tid >> 6, lane = tid & 63, r = lane & 31, h = lane >> 5, comp = wid >> 2, wq = wid & 3;
  const bf16_t* Qb = (const bf16_t*)(p.ws + WS_QB); const bf16_t* Kb = (const bf16_t*)(p.ws + WS_KB); const bf16_t* Vt = (const bf16_t*)(p.ws + WS_VT);
  bf16_t* mix = (bf16_t*)(p.ws + WS_MIX);
  const size_t qrow = (size_t)b * TPB + t0 + wq * 32 + r;
  bf16x8 qf[4];
  { const bf16_t* qp = Qb + qrow * 512 + head * 128 + comp * 64 + 8 * h;
#pragma unroll
    for (int s = 0; s < 4; ++s) qf[s] = *(const bf16x8*)(qp + 16 * s); }
  f32x16 o[4];
#pragma unroll
  for (int k = 0; k < 4; ++k)
#pragma unroll
    for (int i = 0; i < 16; ++i) o[k][i] = 0.f;
  float mrun = -1e30f, lrun = 0.f;
  const float sc = 0.125f * 1.4426950408889634f;
  const char* kg = (const char*)Kb + ((size_t)((b * 4 + head) * 2) * TPB) * 128;
  const char* vg = (const char*)Vt + ((size_t)((b * 4 + head) * 128)) * TPB * 2;
  const unsigned koff[2] = {(unsigned)tid * 16u, (unsigned)tid * 16u + (unsigned)(TPB * 128)};
  const unsigned voff[2] = {(unsigned)(tid >> 3) * (unsigned)(TPB * 2) + (unsigned)(tid & 7) * 16u, (unsigned)((tid >> 3) + 64) * (unsigned)(TPB * 2) + (unsigned)(tid & 7) * 16u};
  const unsigned kl = (unsigned)((tid >> 3) * 144 + (tid & 7) * 16);
  const unsigned vl = (unsigned)(ATT_V + (tid >> 3) * 136 + (tid & 7) * 16);
  u32x4 kr[2], vr[2];
#define ATT_LOAD(kt) do { _Pragma("unroll") for (int i = 0; i < 2; ++i) { \
    kr[i] = *(const u32x4*)(kg + (size_t)(kt) * 8192 + koff[i]); \
    vr[i] = *(const u32x4*)(vg + (size_t)(kt) * 128 + voff[i]); } } while (0)
#define ATT_STORE(buf) do { _Pragma("unroll") for (int i = 0; i < 2; ++i) { \
    *(LAS u32x4*)(lds + (buf) * ATT_BUF + i * ATT_KC + kl) = kr[i]; \
    *(LAS u32x2*)(lds + (buf) * ATT_BUF + i * (64 * 136) + vl) = (u32x2){vr[i].x, vr[i].y}; \
    *(LAS u32x2*)(lds + (buf) * ATT_BUF + i * (64 * 136) + vl + 8) = (u32x2){vr[i].z, vr[i].w}; } } while (0)
  ATT_LOAD(kt0);
  ATT_STORE(0);
  __syncthreads();
  int buf = 0;
  for (int kt = kt0; kt < kt1; ++kt) {
    const bool more = (kt + 1 < kt1);
    if (more) ATT_LOAD(kt + 1);
    const LAS unsigned char* ks = lds + buf * ATT_BUF + comp * ATT_KC + r * 144 + h * 16;
    const LAS unsigned char* vs = lds + buf * ATT_BUF + ATT_V + r * 136 + h * 8;
    bf16x8 kf[8];
#pragma unroll
    for (int kb = 0; kb < 2; ++kb)
#pragma unroll
      for (int s = 0; s < 4; ++s) kf[kb * 4 + s] = *(const LAS bf16x8*)(ks + kb * 4608 + s * 32);
    __builtin_amdgcn_sched_barrier(0);
    f32x16 x[2];
#pragma unroll
    for (int kb = 0; kb < 2; ++kb) {
#pragma unroll
      for (int i = 0; i < 16; ++i) x[kb][i] = 0.f;
#pragma unroll
      for (int s = 0; s < 4; ++s) x[kb] = MFMA32(kf[kb * 4 + s], qf[s], x[kb]);
    }
    s16x4 vlo[8], vhi[8];
#pragma unroll
    for (int s2 = 0; s2 < 2; ++s2)
#pragma unroll
      for (int blk = 0; blk < 4; ++blk) {
        vlo[s2 * 4 + blk] = *(const LAS s16x4*)(vs + blk * 4352 + s2 * 32);
        vhi[s2 * 4 + blk] = *(const LAS s16x4*)(vs + blk * 4352 + s2 * 32 + 16);
      }
    __builtin_amdgcn_sched_barrier(0);
    float mx = x[0][0];
#pragma unroll
    for (int kb = 0; kb < 2; ++kb)
#pragma unroll
      for (int i = 0; i < 16; ++i) mx = fmaxf(mx, x[kb][i]);
    mx = fmaxf(mx, __shfl_xor(mx, 32));
    const float mxs = mx * sc;
    const bool need = mxs > mrun + 8.0f;
    if (__builtin_amdgcn_ballot_w64(need) != 0ull) {
      const float mnew = need ? mxs : mrun;
      const float alpha = __builtin_amdgcn_exp2f(mrun - mnew);
      mrun = mnew; lrun *= alpha;
#pragma unroll
      for (int k = 0; k < 4; ++k)
#pragma unroll
        for (int i = 0; i < 16; ++i) o[k][i] *= alpha;
    }
    float ps = 0.f;
#pragma unroll
    for (int kb = 0; kb < 2; ++kb)
#pragma unroll
      for (int i = 0; i < 16; ++i) { const float e = __builtin_amdgcn_exp2f(x[kb][i] * sc - mrun); x[kb][i] = e; ps += e; }
    lrun += ps;
#pragma unroll
    for (int kb = 0; kb < 2; ++kb) {
      bf16x8 pb[2];
#pragma unroll
      for (int s2 = 0; s2 < 2; ++s2) {
        u32x4 pw; pw.x = pk2(x[kb][8 * s2], x[kb][8 * s2 + 1]); pw.y = pk2(x[kb][8 * s2 + 2], x[kb][8 * s2 + 3]);
        pw.z = pk2(x[kb][8 * s2 + 4], x[kb][8 * s2 + 5]); pw.w = pk2(x[kb][8 * s2 + 6], x[kb][8 * s2 + 7]);
        pb[s2] = __builtin_bit_cast(bf16x8, pw);
      }
#pragma unroll
      for (int s2 = 0; s2 < 2; ++s2)
#pragma unroll
        for (int blk = 0; blk < 4; ++blk) {
          const bf16x8 a = __builtin_shufflevector(vlo[s2 * 4 + blk], vhi[s2 * 4 + blk], 0, 1, 2, 3, 4, 5, 6, 7);
          o[blk] = MFMA32(a, pb[s2], o[blk]);
        }
      if (kb == 0) {
        __builtin_amdgcn_sched_barrier(0);
#pragma unroll
        for (int s2 = 0; s2 < 2; ++s2)
#pragma unroll
          for (int blk = 0; blk < 4; ++blk) {
            vlo[s2 * 4 + blk] = *(const LAS s16x4*)(vs + blk * 4352 + 64 + s2 * 32);
            vhi[s2 * 4 + blk] = *(const LAS s16x4*)(vs + blk * 4352 + 64 + s2 * 32 + 16);
          }
      }
    }
    if (more) ATT_STORE(buf ^ 1);
    __syncthreads();
    buf ^= 1;
  }
#undef ATT_LOAD
#undef ATT_STORE
  const float ltot = lrun + __shfl_xor(lrun, 32);
  const float inv = 1.0f / ltot;
  LAS float* cmb = (LAS float*)lds;
  if (comp == 1) {
#pragma unroll
    for (int k = 0; k < 4; ++k)
#pragma unroll
      for (int i = 0; i < 16; ++i) cmb[(wq * 64 + k * 16 + i) * 64 + lane] = o[k][i] * inv;
  }
  __syncthreads();
  if (comp == 0) {
    float ss = 0.f;
#pragma unroll
    for (int k = 0; k < 4; ++k)
#pragma unroll
      for (int i = 0; i < 16; ++i) { const float d = o[k][i] * inv - lam * cmb[(wq * 64 + k * 16 + i) * 64 + lane]; o[k][i] = d; ss += d * d; }
    ss += __shfl_xor(ss, 32);
    const float rn = __builtin_amdgcn_rsqf(ss * (1.0f / 128.0f) + 1e-5f) * oscale;
    bf16_t* dst = mix + qrow * 1024 + 512 + head * 128;
#pragma unroll
    for (int k = 0; k < 4; ++k)
#pragma unroll
      for (int g4 = 0; g4 < 4; ++g4) {
        const int dv = 32 * k + 8 * g4 + 4 * h;
        const f32x4 gg = *(const f32x4*)(subg + dv);
        u32x2 w; w.x = pk2(o[k][4 * g4] * rn * gg[0], o[k][4 * g4 + 1] * rn * gg[1]); w.y = pk2(o[k][4 * g4 + 2] * rn * gg[2], o[k][4 * g4 + 3] * rn * gg[3]);
        *(u32x2*)(dst + dv) = w;
      }
  }
  __syncthreads();
}

DI void conv_item(const Params& p, int ci, const float* cw) {
  int tid = threadIdx.x; asm volatile("" : "+v"(tid));
  const int cg8 = tid & 63, rr = tid >> 6, c0 = cg8 * 8;
  const bf16_t* P = (const bf16_t*)(p.ws + WS_P); bf16_t* mix = (bf16_t*)(p.ws + WS_MIX);
  float w0[8], w1[8], w2[8];
#pragma unroll
  for (int e = 0; e < 8; ++e) { w0[e] = cw[c0 + e]; w1[e] = cw[512 + c0 + e]; w2[e] = cw[1024 + c0 + e]; }
#pragma unroll 1
  for (int q = 0; q < 4; ++q) {
    const int r = ci * 32 + rr + 8 * q, t = r % TPB;
    const bf16_t* pr = P + (size_t)r * 1536 + c0;
    const u32x4 gb = *(const u32x4*)pr;
    const u32x4 gc1 = *(const u32x4*)(pr + 512), v1 = *(const u32x4*)(pr + 1024);
    u32x4 gc0 = (u32x4){0, 0, 0, 0}, v0 = gc0, gc2 = gc0, v2 = gc0;
    if (t != 0 && t != 4096) { gc0 = *(const u32x4*)(pr - 1536 + 512); v0 = *(const u32x4*)(pr - 1536 + 1024); }
    if (t != 4095 && t != 4351) { gc2 = *(const u32x4*)(pr + 1536 + 512); v2 = *(const u32x4*)(pr + 1536 + 1024); }
    float o[8];
#pragma unroll
    for (int e2 = 0; e2 < 4; ++e2) {
      const float a0 = bflo(gc0[e2]) * bflo(v0[e2]), a1 = bflo(gc1[e2]) * bflo(v1[e2]), a2 = bflo(gc2[e2]) * bflo(v2[e2]);
      const float b0 = bfhi(gc0[e2]) * bfhi(v0[e2]), b1 = bfhi(gc1[e2]) * bfhi(v1[e2]), b2 = bfhi(gc2[e2]) * bfhi(v2[e2]);
      o[2 * e2] = bflo(gb[e2]) * (w0[2 * e2] * a0 + w1[2 * e2] * a1 + w2[2 * e2] * a2);
      o[2 * e2 + 1] = bfhi(gb[e2]) * (w0[2 * e2 + 1] * b0 + w1[2 * e2 + 1] * b1 + w2[2 * e2 + 1] * b2);
    }
    u32x4 w; w.x = pk2(o[0], o[1]); w.y = pk2(o[2], o[3]); w.z = pk2(o[4], o[5]); w.w = pk2(o[6], o[7]);
    *(u32x4*)(mix + (size_t)r * 1024 + c0) = w;
  }
}

DI void attn_phase(LAS unsigned char* lds, const Params& p, int layer) {
  int tid0 = threadIdx.x; asm volatile("" : "+v"(tid0));
  const int j = layer >> 1, lane = tid0 & 63;
  const float lam_init = (layer == 0) ? 0.2f : 0.47071301834382377f;
  const float* lq = p.lam_qk + j * 256;
  const float sa = wave_sum(lq[lane] * lq[64 + lane]), sb = wave_sum(lq[128 + lane] * lq[192 + lane]);
  const float lam = __builtin_amdgcn_exp2f(sa * 1.4426950408889634f) - __builtin_amdgcn_exp2f(sb * 1.4426950408889634f) + lam_init;
  const float oscale = 1.0f - lam_init;
  const float* subg = p.subln_g + j * 128;
  const float* cw = p.conv_w + j * 1536;
  const int natt = 512 + (layer == 0 ? 32 : 0), total = natt + 544;
  for (int it = blockIdx.x; it < total; it += gridDim.x) {
    if (it < 512) {
      const int round = it >> 8, c = it & 255, pair = round * 8 + (c & 7), qblk = c >> 3;
      attn_item(lds, p, pair >> 2, pair & 3, qblk * 128, 0, 68, lam, oscale, subg);
    } else if (it < natt) {
      const int c = it - 512;
      attn_item(lds, p, c >> 3, (c >> 1) & 3, 4096 + (c & 1) * 128, 64, 68, lam, oscale, subg);
    } else conv_item(p, it - natt, cw);
  }
}

__global__ void __launch_bounds__(512, 2) fwd_megakernel(Params p) {
  extern __shared__ __attribute__((aligned(16))) unsigned char shm[];
  LAS unsigned char* lds = (LAS unsigned char*)shm;
  cg::grid_group grid = cg::this_grid();
  unsigned char* ws = p.ws;
  const float* mod = (const float*)(ws + WS_MOD);
  bf16_t* U = (bf16_t*)(ws + WS_U); bf16_t* Y = (bf16_t*)(ws + WS_Y);

  unsigned* bar = (unsigned*)(ws + WS_BAR);
  volatile LAS unsigned* xst = (volatile LAS unsigned*)(lds + 131072);
  if (blockIdx.x == 0) for (int i = threadIdx.x; i < XCD_BAR_WORDS; i += 512) __hip_atomic_store(&bar[i], 0u, __ATOMIC_RELAXED, __HIP_MEMORY_SCOPE_AGENT);
  if (threadIdx.x == 0) { xst[0] = 0u; xst[1] = 0u; }
  __syncthreads();
  for (int rep = 0; rep < REP_P0; ++rep) { phase0(lds, p); __syncthreads(); }
  grid.sync();
  const XcdBarrier xb = xcd_barrier_post(bar, xst);
#define GSYNC() xcd_barrier(xb)
  phase0b(p);
  GSYNC();
  ln_pass(p, true, nullptr, nullptr, nullptr, mod + 0, mod + 1024, false, false, 0);
  GSYNC();

  bf16_t* PART = (bf16_t*)p.out;
  for (int layer = 0; layer < 4; ++layer) {
    const int j = layer >> 1;
    const float* lmod = mod + (size_t)layer * 30720;
    const bool ctx_alive = layer < 2;
    int nks_mid = 0;
    if ((layer & 1) == 0) {
      { Gemm g{U, (const bf16_t*)(ws + WS_WIN) + (size_t)j * 3145728, NROW, 2560, 1024, 0, 1, 0, 1024, 1024};
        Epi<EP_QKC> e{(bf16_t*)(ws + WS_P), (bf16_t*)(ws + WS_QB), (bf16_t*)(ws + WS_KB), (const float*)(ws + WS_ROPE), (const float*)(ws + WS_ROPE) + 1024, 0, 0, 0};
        for (int rep = 0; rep < REP_GEMM * REP_E1A; ++rep) gemm_phase(lds, g, e); }
      { Gemm g{(const bf16_t*)(ws + WS_WIN) + (size_t)j * 3145728 + (size_t)2560 * 1024, U, 512, NROW, 1024, 0, 1, 0, 1024, 1024};
        Epi<EP_VT> e{(bf16_t*)(ws + WS_VT), nullptr, nullptr, nullptr, nullptr, 0, 0, 0};
        for (int rep = 0; rep < REP_GEMM * REP_E1V; ++rep) gemm_phase(lds, g, e); }
      GSYNC();
      for (int rep = 0; rep < REP_ATT; ++rep) attn_phase(lds, p, layer);
      GSYNC();
      { Gemm g{(const bf16_t*)(ws + WS_MIX), (const bf16_t*)(ws + WS_WOM) + (size_t)j * 1048576, 16384, 1024, 1024, 1, 1, 0, 1024, 1024};
        Epi<EP_PLAIN> e{Y, nullptr, nullptr, nullptr, nullptr, 1024, 0, 0};
        for (int rep = 0; rep < REP_GEMM * REP_E3L; ++rep) gemm_phase(lds, g, e); }
      if (ctx_alive) {
        Gemm g{(const bf16_t*)(ws + WS_MIX), (const bf16_t*)(ws + WS_WOM) + (size_t)j * 1048576, 4096, 1024, 256, 4, 4, 0, 1024, 1024};
        Epi<EP_PLAIN> e{PART, nullptr, nullptr, nullptr, nullptr, 1024, 4, 4};
        for (int rep = 0; rep < REP_GEMM * REP_E3C; ++rep) gemm_phase(lds, g, e);
        nks_mid = 4;
      }
      GSYNC();
    } else {
      { Gemm g{(const bf16_t*)(ws + WS_W12) + (size_t)j * 2097152, U, 2048, ctx_alive ? NROW : 16384, 1024, ctx_alive ? 0 : 2, 1, 0, 1024, 1024};
        Epi<EP_ZT> e{(bf16_t*)(ws + WS_ZT), (bf16_t*)(ws + WS_ZTC), nullptr, nullptr, nullptr, 0, 0, 0};
        for (int rep = 0; rep < REP_GEMM * REP_O1; ++rep) gemm_phase(lds, g, e); }
      GSYNC();
      fft16_pass(p);
      GSYNC();
      { Gemm g{(const bf16_t*)(ws + WS_DN2), (const bf16_t*)(ws + WS_WT), 16384, 1024, 512, 3, 1, (size_t)1024 * 512 * 2, 512, 512};
        Epi<EP_PLAIN> e{Y, nullptr, nullptr, nullptr, nullptr, 1024, 3, 0};
        for (int rep = 0; rep < REP_GEMM * REP_O2L; ++rep) gemm_phase(lds, g, e); }
      if (ctx_alive) {
        Gemm g{(const bf16_t*)(ws + WS_DN256), (const bf16_t*)(ws + WS_ZTC), 1024, 1024, 512, 3, 1, (size_t)1024 * 512 * 2, 512, 512};
        Epi<EP_PLAIN> e{Y, nullptr, nullptr, nullptr, nullptr, 1024, 2, 0};
        for (int rep = 0; rep < REP_GEMM * REP_O2C; ++rep) gemm_phase(lds, g, e);
      }
      GSYNC();
    }
    ln_pass(p, false, lmod + 2048, p.ln_g + (size_t)(layer * 2) * 1024, p.ln_b + (size_t)(layer * 2) * 1024, lmod + 3072, lmod + 4096, false, !ctx_alive, nks_mid);
    GSYNC();
    { Gemm g{U, (const bf16_t*)(ws + WS_W1) + (size_t)layer * 4194304, ctx_alive ? NROW : 16384, 4096, 1024, ctx_alive ? 0 : 1, 1, 0, 1024, 1024};
      Epi<EP_RELU2> e{(bf16_t*)(ws + WS_HID), nullptr, nullptr, nullptr, nullptr, 4096, 0, 0};
      for (int rep = 0; rep < REP_GEMM * REP_M1; ++rep) gemm_phase(lds, g, e); }
    GSYNC();
    { Gemm g{(const bf16_t*)(ws + WS_HID), (const bf16_t*)(ws + WS_W2) + (size_t)layer * 4194304, 16384, 1024, 4096, 1, 1, 0, 4096, 4096};
      Epi<EP_PLAIN> e{Y, nullptr, nullptr, nullptr, nullptr, 1024, 0, 0};
      for (int rep = 0; rep < REP_GEMM * REP_M2L; ++rep) gemm_phase(lds, g, e); }
    if (ctx_alive) {
      Gemm g{(const bf16_t*)(ws + WS_HID), (const bf16_t*)(ws + WS_W2) + (size_t)layer * 4194304, 16384, 1024, 256, 4, 16, 0, 4096, 4096};
      Epi<EP_PLAIN> e{PART, nullptr, nullptr, nullptr, nullptr, 1024, 4, 16};
      for (int rep = 0; rep < REP_GEMM * REP_M2C; ++rep) gemm_phase(lds, g, e);
    }
    GSYNC();
    const bool lat_only_end = layer >= 2;
    const float* nmod = mod + (size_t)(layer + 1) * 30720;
    ln_pass(p, false, lmod + 5120, p.ln_g + (size_t)(layer * 2 + 1) * 1024, p.ln_b + (size_t)(layer * 2 + 1) * 1024, nmod + 0, nmod + 1024, layer == 3, lat_only_end, ctx_alive ? 16 : 0);
    if (layer < 3) { for (int rep = 0; rep < 1 + 10 * (REP_SYNC - 1); ++rep) GSYNC(); }
  }
}

extern "C" void kernel_launch(void* const* d_in, const int* in_sizes, int n_in, void* d_out, int out_size, void* d_ws, size_t ws_size, hipStream_t stream) {
  constexpr size_t kDynLds = 131072 + 256;
  static int grid_blocks = 0;
  if (!grid_blocks) {
    int dev = 0, cus = 0, per_cu = 0;
    (void)hipGetDevice(&dev);
    (void)hipDeviceGetAttribute(&cus, hipDeviceAttributeMultiprocessorCount, dev);
    (void)hipFuncSetAttribute((const void*)fwd_megakernel, hipFuncAttributeMaxDynamicSharedMemorySize, (int)kDynLds);
    (void)hipOccupancyMaxActiveBlocksPerMultiprocessor(&per_cu, (const void*)fwd_megakernel, 512, kDynLds);
    if (per_cu < 1) per_cu = 1;
    if (per_cu > 1) per_cu = 1;
    grid_blocks = cus * per_cu;
    if (ws_size < WS_END) fprintf(stderr, "kernel_launch: workspace too small: %zu < %zu\n", ws_size, (size_t)WS_END);
  }
  Params p{};
  p.x = (const float*)d_in[0]; p.c = (const float*)d_in[1]; p.ctx = (const float*)d_in[2]; p.c_ctx = (const float*)d_in[3];
  p.ada_w = (const float*)d_in[4]; p.ada_b = (const float*)d_in[5]; p.ln_g = (const float*)d_in[6]; p.ln_b = (const float*)d_in[7];
  p.w1 = (const float*)d_in[8]; p.w2 = (const float*)d_in[9]; p.w_in = (const float*)d_in[10]; p.conv_w = (const float*)d_in[11];
  p.lam_qk = (const float*)d_in[12]; p.subln_g = (const float*)d_in[13]; p.w_out_mix = (const float*)d_in[14]; p.w_out_f = (const float*)d_in[15];
  p.out = (float*)d_out; p.ws = (unsigned char*)d_ws;
  void* args[] = {&p};
  hipError_t e = hipLaunchCooperativeKernel((void*)fwd_megakernel, dim3(grid_blocks), dim3(512), args, kDynLds, stream);
  if (e != hipSuccess) fprintf(stderr, "cooperative launch failed: %s (grid %d)\n", hipGetErrorString(e), grid_blocks);
}
```

```cpp
#include <hip/hip_runtime.h>
#include <hip/hip_cooperative_groups.h>
#include <cstdio>
namespace cg = cooperative_groups;
#ifndef REP_P0
#define REP_P0 1
#endif
#ifndef REP_ATT
#define REP_ATT 1
#endif
#ifndef REP_GEMM
#define REP_GEMM 1
#endif
#ifndef REP_E1A
#define REP_E1A 1
#endif
#ifndef REP_E1V
#define REP_E1V 1
#endif
#ifndef REP_E3L
#define REP_E3L 1
#endif
#ifndef REP_E3C
#define REP_E3C 1
#endif
#ifndef REP_O1
#define REP_O1 1
#endif
#ifndef REP_O2L
#define REP_O2L 1
#endif
#ifndef REP_O2C
#define REP_O2C 1
#endif
#ifndef REP_M1
#define REP_M1 1
#endif
#ifndef REP_M2L
#define REP_M2L 1
#endif
#ifndef REP_M2C
#define REP_M2C 1
#endif
#ifndef REP_SYNC
#define REP_SYNC 1
#endif

#define LAS __attribute__((address_space(3)))
#define DI __device__ __forceinline__
typedef unsigned short bf16_t;
typedef short bf16x8 __attribute__((ext_vector_type(8)));
typedef short s16x4 __attribute__((ext_vector_type(4)));
typedef float f32x4 __attribute__((ext_vector_type(4)));
typedef float f32x2 __attribute__((ext_vector_type(2)));
typedef float f32x16 __attribute__((ext_vector_type(16)));
typedef unsigned u32x4 __attribute__((ext_vector_type(4)));
typedef unsigned u32x2 __attribute__((ext_vector_type(2)));
typedef __bf16 bf2_t __attribute__((ext_vector_type(2)));

constexpr int TPB = 4352;
constexpr int NROW = 17408;
constexpr float ALPHA = 1.681792830507429f;

constexpr size_t WS_WIN = 0;
constexpr size_t WS_W1 = WS_WIN + 12582912;
constexpr size_t WS_W2 = WS_W1 + 33554432;
constexpr size_t WS_WOM = WS_W2 + 33554432;
constexpr size_t WS_W12 = WS_WOM + 4194304;
constexpr size_t WS_H = WS_W12 + 8388608;
constexpr size_t WS_U = WS_H + 71303168;
constexpr size_t WS_Y = WS_U + 35651584;
constexpr size_t WS_BIG = WS_Y + 35651584;
constexpr size_t WS_P = WS_BIG;
constexpr size_t WS_QB = WS_BIG + 53477376;
constexpr size_t WS_KB = WS_QB + 17825792;
constexpr size_t WS_VT = WS_KB + 17825792;
constexpr size_t WS_MIX = WS_VT + 17825792;
constexpr size_t WS_HID = WS_BIG;
constexpr size_t WS_ZT = WS_BIG;
constexpr size_t WS_ZTC = WS_BIG + 67108864;
constexpr size_t WS_WT = WS_ZTC + 4194304;
constexpr size_t WS_MODP = WS_BIG + 142606336;
constexpr size_t WS_MOD = WS_MODP + 15728640;
constexpr size_t WS_ROPE = WS_MOD + 491520;
constexpr size_t WS_DN256 = WS_ROPE + 8192;
constexpr size_t WS_BAR = WS_DN256 + 262144;
constexpr size_t WS_DN2 = WS_BAR + 16384;
constexpr size_t WS_END = WS_DN2 + 262144;

struct Params {
  const float *x, *c, *ctx, *c_ctx, *ada_w, *ada_b, *ln_g, *ln_b, *w1, *w2, *w_in, *conv_w, *lam_qk, *subln_g, *w_out_mix, *w_out_f;
  float* out; unsigned char* ws;
};

DI unsigned pk2(float a, float b) { f32x2 v = {a, b}; bf2_t r = __builtin_convertvector(v, bf2_t); return __builtin_bit_cast(unsigned, r); }
DI float bflo(unsigned w) { return __uint_as_float(w << 16); }
DI float bfhi(unsigned w) { return __uint_as_float(w & 0xffff0000u); }
DI float wave_sum(float v) {
#pragma unroll
  for (int o = 32; o >= 1; o >>= 1) v += __shfl_xor(v, o);
  return v;
}


#define XB_TMO      128
#define XB_XCNT(j)  (256  + 64 * (j))
#define XB_XSUB(j)  (1280 + 64 * (j))
#define XB_XGEN(j)  (2304 + 64 * (j))
#define XB_TOP      3328
#define XB_TOPGEN   3392
#define XCD_BAR_WORDS 3456
#define XB_SPIN_CAP (1u << 20)
DI unsigned xb_ld(unsigned* p)              { return __hip_atomic_load(p, __ATOMIC_RELAXED, __HIP_MEMORY_SCOPE_AGENT); }
DI unsigned xb_add(unsigned* p, unsigned v) { return __hip_atomic_fetch_add(p, v, __ATOMIC_RELAXED, __HIP_MEMORY_SCOPE_AGENT); }
DI unsigned xb_xcc_id() { return (unsigned)__builtin_amdgcn_s_getreg((3 << 11) | 20) & 0xFu; }
#define XB_SPIN(cond, bar) do { unsigned _sp = 0; while (cond) { __builtin_amdgcn_s_sleep(1); \
    if ((++_sp & 255u) == 0u) { if (xb_ld(&(bar)[XB_TMO])) break; if (_sp > XB_SPIN_CAP) { atomicAdd(&(bar)[XB_TMO], 1u); break; } } } } while (0)
struct XcdBarrier { unsigned* bar; unsigned x; volatile LAS unsigned* st; };
DI XcdBarrier xcd_barrier_post(unsigned* bar, volatile LAS unsigned* st) {
  XcdBarrier b; b.bar = bar; b.x = xb_xcc_id(); b.st = st;
  if (threadIdx.x == 0) (void)xb_add(&bar[XB_XCNT(b.x)], 1u);
  return b;
}
DI void xcd_barrier_complete(unsigned* bar, unsigned x, unsigned& nloc, unsigned& nx) {
  const unsigned G = gridDim.x * gridDim.y * gridDim.z;
  unsigned sum, cnt, mine, sp = 0u;
  for (;;) {
    sum = 0u; cnt = 0u; mine = 0u;
#pragma unroll
    for (unsigned j = 0; j < 16; ++j) { const unsigned c = xb_ld(&bar[XB_XCNT(j)]); sum += c; cnt += (c > 0u) ? 1u : 0u; mine = (j == x) ? c : mine; }
    if (sum == G) break;
    __builtin_amdgcn_s_sleep(1);
    if ((++sp & 255u) == 0u) { if (xb_ld(&bar[XB_TMO])) break; if (sp > XB_SPIN_CAP) { atomicAdd(&bar[XB_TMO], 1u); break; } }
  }
  nloc = mine > 0u ? mine : 1u; nx = cnt > 0u ? cnt : 1u;
}
DI void xcd_barrier(const XcdBarrier& b) {
  asm volatile("s_waitcnt vmcnt(0)" ::: "memory");
  __syncthreads();
  if (threadIdx.x == 0) {
    unsigned* bar = b.bar;
    __builtin_amdgcn_s_waitcnt(0);
    unsigned nloc = b.st[0], nx = b.st[1];
    if (nloc == 0u) { xcd_barrier_complete(bar, b.x, nloc, nx); b.st[0] = nloc; b.st[1] = nx; }
    const unsigned old = xb_add(&bar[XB_XSUB(b.x)], 1u);
    const unsigned gen = old / nloc;
    if (old + 1u == (gen + 1u) * nloc) {
      __builtin_amdgcn_fence(__ATOMIC_RELEASE, "agent");
      asm volatile("s_waitcnt vmcnt(0)" ::: "memory");
      const unsigned og = xb_add(&bar[XB_TOP], 1u);
      const unsigned tg = og / nx;
      if (og + 1u == (tg + 1u) * nx) xb_add(&bar[XB_TOPGEN], 1u);
      else XB_SPIN(xb_ld(&bar[XB_TOPGEN]) == tg, bar);
      __builtin_amdgcn_fence(__ATOMIC_ACQUIRE, "agent");
      xb_add(&bar[XB_XGEN(b.x)], 1u);
      asm volatile("s_waitcnt vmcnt(0)" ::: "memory");
    } else {
      XB_SPIN(xb_ld(&bar[XB_XGEN(b.x)]) == gen, bar);
      __builtin_amdgcn_fence(__ATOMIC_ACQUIRE, "agent");
      asm volatile("s_waitcnt vmcnt(0)" ::: "memory");
    }
  }
  __syncthreads();
}

constexpr int BM = 256, BK = 64, HALF = 128, HTB = HALF * BK * 2, STAGE_BYTES = 8 * HTB, NXCD = 8, WGM = 8;
DI int lds_byte(int r, int c) { const int st = (r >> 4) * 2 + (c >> 5), rr = r & 15, cc = c & 31, ob = rr * 64 + cc * 2; return st * 1024 + (ob ^ (((ob >> 9) & 1) << 5)); }
DI void stage_rc(int b, int& R, int& C) { const int st = b / 1024, sb = b % 1024, swz = sb ^ (((sb >> 9) & 1) << 5); R = (st >> 1) * 16 + swz / 64; C = (st & 1) * 32 + (swz % 64) / 2; }
DI int perm32(int rho) { const int n = rho >> 4, i = rho & 15; return 8 * (i >> 2) + 4 * n + (i & 3); }

struct Unit { int pm, pn; };
struct Gemm { const bf16_t* A; const bf16_t* Bt; int M, N, K; int mode; int a_mod; size_t bstride; int lda, ldb; };

struct StaticOrder {
  int nM, nN, nwg, G, c;
  DI void init(int M, int N, int G_, int c_) { nM = M / BM; nN = N / BM; nwg = nM * nN; G = G_; c = c_; }
  DI bool next(int i, Unit& u) const {
    const long L = (long)i * G + c; if (L >= nwg) return false;
    int wgid = (int)L; { const int q = nwg / NXCD, r = nwg % NXCD, xcd = wgid % NXCD, off = wgid / NXCD; wgid = (xcd < r ? xcd * (q + 1) : r * (q + 1) + (xcd - r) * q) + off; }
    const int nig = WGM * nN, gid = wgid / nig, fm = gid * WGM, gsz = (nM - fm) < WGM ? (nM - fm) : WGM;
    u.pm = fm + ((wgid % nig) % gsz); u.pn = (wgid % nig) / gsz; return true;
  }
};

DI void unit_ptrs(const Gemm& g, const Unit& v, size_t tstepA, size_t tstepB, const char*& cA, const char*& cB, Unit& real) {
  int pm = v.pm, pn = v.pn, pa = v.pm, pb = v.pn; size_t boff = 0, aoff = 0;
  if (g.mode == 1) { pm = pm + pm / 16; pa = pm; }
  else if (g.mode == 2) { pn = pn + pn / 16; pb = pn; }
  else if (g.mode == 3) { pa = pm % g.a_mod; boff = (size_t)(pm / g.a_mod) * g.bstride; }
  else if (g.mode == 4) { const int bb = pm / g.a_mod, ks = pm % g.a_mod; pa = 0; aoff = ((size_t)(bb * TPB + 4096) * g.lda + (size_t)ks * 256) * 2; boff = (size_t)ks * 512; }
  cA = (const char*)g.A + aoff + (size_t)pa * tstepA; cB = (const char*)g.Bt + boff + (size_t)pb * tstepB; real.pm = pm; real.pn = pn;
}

template <class Epi>
DI void gemm_phase(LAS unsigned char* lds, const Gemm g, const Epi& E) {
  int tid = threadIdx.x; asm volatile("" : "+v"(tid));
  const int wid = __builtin_amdgcn_readfirstlane(tid >> 6), lane = tid & 63, wr = wid >> 2, wc = wid & 3, fr = lane & 15, fq = lane >> 4;
  const int K = g.K, nt = K / BK;
  StaticOrder S; S.init(g.M, g.N, (int)gridDim.x, (int)blockIdx.x);
  unsigned voffA[2], voffB[2];
#pragma unroll
  for (int i = 0; i < 2; ++i) { int R, C; stage_rc(tid * 16 + i * 8192, R, C); const int Rb = Epi::PERM ? ((R & ~31) + perm32(R & 31)) : R;
    voffA[i] = (unsigned)(R * g.lda + C) * 2u; voffB[i] = (unsigned)(Rb * g.ldb + C) * 2u; }
  const size_t kstep = (size_t)(BK * 2);
  const size_t hstepA = (size_t)HALF * g.lda * 2, hstepB = (size_t)HALF * g.ldb * 2;
  const size_t tstepA = 2 * hstepA, tstepB = 2 * hstepB;
  const unsigned ldsw = (unsigned)wid * 1024u;
  const int aoff = lds_byte(wr * 64 + fr, fq * 8), boff = lds_byte(wc * 32 + fr, fq * 8);
#define PG8_SA(b, h) (((b) * 2 + (h)) * HTB)
#define PG8_SB(b, h) ((4 + (b) * 2 + (h)) * HTB)
#define PG8_STAGE(bufoff, gbase, voff) do { _Pragma("unroll") for (int _i = 0; _i < 2; ++_i) \
        __builtin_amdgcn_global_load_lds((const unsigned*)((const char*)(gbase) + (voff)[_i]), (LAS unsigned*)(lds + (bufoff) + ldsw + _i * 8192), 16, 0, 0); } while (0)
#define PG8_LDA(dst, b, h) do { _Pragma("unroll") for (int m = 0; m < 4; ++m) _Pragma("unroll") for (int k = 0; k < 2; ++k) dst[m][k] = *(const LAS bf16x8*)(lds + PG8_SA(b, h) + aoff + m * 2048 + k * 1024); } while (0)
#define PG8_LDB(dst, b, h) do { _Pragma("unroll") for (int n = 0; n < 2; ++n) _Pragma("unroll") for (int k = 0; k < 2; ++k) dst[n][k] = *(const LAS bf16x8*)(lds + PG8_SB(b, h) + boff + n * 2048 + k * 1024); } while (0)
#define PG8_MMA(ai, bj, At, Bt) do { __builtin_amdgcn_s_setprio(1); _Pragma("unroll") for (int m = 0; m < 4; ++m) _Pragma("unroll") for (int n = 0; n < 2; ++n) _Pragma("unroll") for (int k = 0; k < 2; ++k) \
        acc[ai][bj][m][n] = __builtin_amdgcn_mfma_f32_16x16x32_bf16(Bt[n][k], At[m][k], acc[ai][bj][m][n], 0, 0, 0); __builtin_amdgcn_s_setprio(0); } while (0)
#define PG8_WAIT_V(n) asm volatile("s_waitcnt vmcnt(" #n ")" ::: "memory")
#define PG8_WAIT_L(n) asm volatile("s_waitcnt lgkmcnt(" #n ")" ::: "memory")
#define PG8_BAR __builtin_amdgcn_s_barrier()
#define PG8_SCHED __builtin_amdgcn_sched_barrier(0)
  Unit cur, nxt, curR, nxtR; int ui = 0;
  if (!S.next(0, cur)) return;
  f32x4 acc[2][2][4][2];
#pragma unroll
  for (int a = 0; a < 2; ++a)
#pragma unroll
    for (int b = 0; b < 2; ++b)
#pragma unroll
      for (int m = 0; m < 4; ++m)
#pragma unroll
        for (int n = 0; n < 2; ++n) acc[a][b][m][n] = (f32x4){0.f, 0.f, 0.f, 0.f};
  bf16x8 At[4][2], B0[2][2], B1[2][2];
  const char* cA; const char* cB;
  unit_ptrs(g, cur, tstepA, tstepB, cA, cB, curR);
  PG8_STAGE(PG8_SB(0, 0), cB, voffB); PG8_STAGE(PG8_SA(0, 0), cA, voffA); PG8_STAGE(PG8_SB(0, 1), cB + hstepB, voffB); PG8_STAGE(PG8_SA(0, 1), cA + hstepA, voffA);
  if (wr == 1) PG8_BAR;
  PG8_WAIT_V(4); PG8_BAR;
  PG8_STAGE(PG8_SB(1, 0), cB + kstep, voffB); PG8_STAGE(PG8_SA(1, 0), cA + kstep, voffA); PG8_STAGE(PG8_SB(1, 1), cB + hstepB + kstep, voffB);
  PG8_WAIT_V(6); PG8_BAR;
  for (;;) {
    const bool has_next = S.next(ui + 1, nxt);
    const char* nA = cA; const char* nB = cB; nxtR = curR;
    if (has_next) unit_ptrs(g, nxt, tstepA, tstepB, nA, nB, nxtR);
    for (int t = 0; t < nt; t += 2) {
      const bool last = (t == nt - 2);
      const char* a1 = cA + (size_t)(t + 1) * kstep;
      const char* a2 = last ? nA : cA + (size_t)(t + 2) * kstep; const char* b2 = last ? nB : cB + (size_t)(t + 2) * kstep;
      const char* a3 = a2 + kstep; const char* b3 = b2 + kstep;
      PG8_LDB(B0, 0, 0); PG8_SCHED; PG8_LDA(At, 0, 0); PG8_STAGE(PG8_SA(1, 1), a1 + hstepA, voffA);
      PG8_WAIT_L(8); PG8_BAR; PG8_WAIT_L(0); PG8_MMA(0, 0, At, B0); PG8_BAR; PG8_SCHED;
      PG8_LDB(B1, 0, 1); PG8_STAGE(PG8_SB(0, 0), b2, voffB);
      PG8_BAR; PG8_WAIT_L(0); PG8_MMA(0, 1, At, B1); PG8_BAR;
      PG8_LDA(At, 0, 1); PG8_STAGE(PG8_SA(0, 0), a2, voffA);
      PG8_BAR; PG8_WAIT_L(0); PG8_MMA(1, 0, At, B0); PG8_BAR; PG8_SCHED;
      PG8_STAGE(PG8_SB(0, 1), b2 + hstepB, voffB);
      PG8_WAIT_V(6); PG8_BAR; PG8_MMA(1, 1, At, B1); PG8_BAR;
      PG8_LDB(B0, 1, 0); PG8_SCHED; PG8_LDA(At, 1, 0); PG8_STAGE(PG8_SA(0, 1), a2 + hstepA, voffA);
      PG8_WAIT_L(8); PG8_BAR; PG8_WAIT_L(0); PG8_MMA(0, 0, At, B0); PG8_BAR; PG8_SCHED;
      PG8_LDB(B1, 1, 1); PG8_STAGE(PG8_SB(1, 0), b3, voffB);
      PG8_BAR; PG8_WAIT_L(0); PG8_MMA(0, 1, At, B1); PG8_BAR;
      PG8_LDA(At, 1, 1); PG8_STAGE(PG8_SA(1, 0), a3, voffA);
      PG8_BAR; PG8_WAIT_L(0); PG8_MMA(1, 0, At, B0); PG8_BAR; PG8_SCHED;
      PG8_STAGE(PG8_SB(1, 1), b3 + hstepB, voffB);
      PG8_WAIT_V(6); PG8_BAR; PG8_MMA(1, 1, At, B1); PG8_BAR;
    }
    E(acc, curR, wr, wc, fr, fq);
    if (!has_next) break;
#pragma unroll
    for (int a = 0; a < 2; ++a)
#pragma unroll
      for (int b = 0; b < 2; ++b)
#pragma unroll
        for (int m = 0; m < 4; ++m)
#pragma unroll
          for (int n = 0; n < 2; ++n) acc[a][b][m][n] = (f32x4){0.f, 0.f, 0.f, 0.f};
    cur = nxt; curR = nxtR; cA = nA; cB = nB; ++ui;
  }
  PG8_WAIT_V(0);
  if (wr == 0) PG8_BAR;
  PG8_BAR;
#undef PG8_SA
#undef PG8_SB
#undef PG8_STAGE
#undef PG8_LDA
#undef PG8_LDB
#undef PG8_MMA
#undef PG8_WAIT_V
#undef PG8_WAIT_L
#undef PG8_BAR
#undef PG8_SCHED
}

DI void store8(bf16_t* dst, const f32x4& a, const f32x4& b) {
  u32x4 w; w.x = pk2(a[0], a[1]); w.y = pk2(a[2], a[3]); w.z = pk2(b[0], b[1]); w.w = pk2(b[2], b[3]);
  *(u32x4*)dst = w;
}
enum { EP_PLAIN = 0, EP_RELU2 = 1, EP_QKC = 2, EP_VT = 3, EP_ZT = 4 };
template <int MODE> struct Epi {
  static constexpr bool PERM = true;
  bf16_t* O; bf16_t* O2; bf16_t* O3; const float* ropec; const float* ropes; int ldc; int rowmap; int aux;
  DI void operator()(const f32x4 (&acc)[2][2][4][2], const Unit& u, int wr, int wc, int fr, int fq) const {
    if constexpr (MODE == EP_PLAIN || MODE == EP_RELU2) {
      int rowbase = u.pm * 256;
      if (rowmap == 1) rowbase = (u.pm / 16) * TPB + (u.pm % 16) * 256;
      else if (rowmap == 2) rowbase = u.pm * TPB + 4096;
      const int rmul = (rowmap == 3) ? 16 : 1;
      if (rowmap == 3) rowbase = (u.pm / 16) * TPB + (u.pm % 16);
      if (rowmap == 4) rowbase = (u.pm % aux) * 1024 + (u.pm / aux) * 256;
#pragma unroll
      for (int ai = 0; ai < 2; ++ai)
#pragma unroll
        for (int m = 0; m < 4; ++m) {
          const size_t row = (size_t)(rowbase + rmul * (ai * 128 + wr * 64 + m * 16 + fr));
#pragma unroll
          for (int bj = 0; bj < 2; ++bj) {
            const int col = u.pn * 256 + bj * 128 + wc * 32 + 8 * fq;
            f32x4 v0 = acc[ai][bj][m][0], v1 = acc[ai][bj][m][1];
            if constexpr (MODE == EP_RELU2) {
#pragma unroll
              for (int e = 0; e < 4; ++e) { float a = fmaxf(v0[e], 0.f), b = fmaxf(v1[e], 0.f); v0[e] = a * a; v1[e] = b * b; }
            }
            store8(O + row * ldc + col, v0, v1);
          }
        }
    } else if constexpr (MODE == EP_QKC) {
      const int pn = u.pn, b = u.pm / 17, pmr = u.pm % 17; const bool latent = pmr < 16;
#pragma unroll
      for (int ai = 0; ai < 2; ++ai)
#pragma unroll
        for (int m = 0; m < 4; ++m) {
          const int t = pmr * 256 + ai * 128 + wr * 64 + m * 16 + fr;
          const size_t row = (size_t)b * TPB + t;
#pragma unroll
          for (int bj = 0; bj < 2; ++bj) {
            const int col = pn * 256 + bj * 128 + wc * 32 + 8 * fq;
            f32x4 v0 = acc[ai][bj][m][0], v1 = acc[ai][bj][m][1];
            if (pn < 6) { store8(O + row * 1536 + col, v0, v1); }
            else {
              if (latent) {
                const int pos = (wc & 1) ? (t & 63) : (t >> 6);
                const float* cp = ropec + pos * 16 + 8 * (fq & 1); const float* sp = ropes + pos * 16 + 8 * (fq & 1);
                const f32x4 c0 = *(const f32x4*)cp, c1 = *(const f32x4*)(cp + 4), s0 = *(const f32x4*)sp, s1 = *(const f32x4*)(sp + 4);
                const float sgn = (fq < 2) ? -1.f : 1.f;
#pragma unroll
                for (int e = 0; e < 4; ++e) {
                  const float p0 = __shfl_xor(v0[e], 32), p1 = __shfl_xor(v1[e], 32);
                  v0[e] = v0[e] * c0[e] + sgn * p0 * s0[e];
                  v1[e] = v1[e] * c1[e] + sgn * p1 * s1[e];
                }
              }
              if (pn < 8) { store8(O2 + row * 512 + (col - 1536), v0, v1); }
              else {
                const int head = (pn - 8) * 2 + bj, comp = wc >> 1, d0 = (wc & 1) * 32 + 8 * fq;
                store8(O3 + ((size_t)((b * 4 + head) * 2 + comp) * TPB + t) * 64 + d0, v0, v1);
              }
            }
          }
        }
    } else if constexpr (MODE == EP_VT) {
      const int b = u.pn / 17, pnr = u.pn % 17;
#pragma unroll
      for (int ai = 0; ai < 2; ++ai)
#pragma unroll
        for (int m = 0; m < 4; ++m) {
          const int n = u.pm * 256 + ai * 128 + wr * 64 + m * 16 + fr; const int head = n >> 7, dv = n & 127;
#pragma unroll
          for (int bj = 0; bj < 2; ++bj) {
            const int t = pnr * 256 + bj * 128 + wc * 32 + 8 * fq;
            store8(O + ((size_t)((b * 4 + head) * 128 + dv)) * TPB + t, acc[ai][bj][m][0], acc[ai][bj][m][1]);
          }
        }
    } else {
      const int b = u.pn / 17, pnr = u.pn % 17;
#pragma unroll
      for (int ai = 0; ai < 2; ++ai)
#pragma unroll
        for (int m = 0; m < 4; ++m) {
          const int n = u.pm * 256 + ai * 128 + wr * 64 + m * 16 + fr; const int part = n >> 10, ch = n & 1023;
#pragma unroll
          for (int bj = 0; bj < 2; ++bj) {
            const int tt = pnr * 256 + bj * 128 + wc * 32 + 8 * fq;
            bf16_t* dst = (pnr < 16) ? O + ((size_t)(b * 1024 + ch)) * 8192 + part * 4096 + tt
                                     : O2 + ((size_t)(b * 1024 + ch)) * 512 + part * 256 + (tt - 4096);
            store8(dst, acc[ai][bj][m][0], acc[ai][bj][m][1]);
          }
        }
    }
  }
};

DI void tr_item(LAS float* tile, const float* src, bf16_t* dst, int K, int N, int tk, int tn) {
  const int tid = threadIdx.x;
  f32x4 v[8];
#pragma unroll
  for (int i = 0; i < 8; ++i) { const int idx = tid + 512 * i, k = idx >> 6, n4 = (idx & 63) * 4; v[i] = *(const f32x4*)(src + (size_t)(tk * 64 + k) * N + tn * 256 + n4); }
#pragma unroll
  for (int i = 0; i < 8; ++i) { const int idx = tid + 512 * i, k = idx >> 6, n4 = (idx & 63) * 4;
    tile[k * 257 + n4 + 0] = v[i][0]; tile[k * 257 + n4 + 1] = v[i][1]; tile[k * 257 + n4 + 2] = v[i][2]; tile[k * 257 + n4 + 3] = v[i][3]; }
  __syncthreads();
#pragma unroll
  for (int i = 0; i < 4; ++i) {
    const int jx = tid + 512 * i, n = jx >> 3, k0 = (jx & 7) * 8;
    float e[8];
#pragma unroll
    for (int q = 0; q < 8; ++q) e[q] = tile[(k0 + q) * 257 + n];
    u32x4 w; w.x = pk2(e[0], e[1]); w.y = pk2(e[2], e[3]); w.z = pk2(e[4], e[5]); w.w = pk2(e[6], e[7]);
    *(u32x4*)(dst + (size_t)(tn * 256 + n) * K + tk * 64 + k0) = w;
  }
  __syncthreads();
}

DI void w12_item(LAS float* trig, const Params& p, int it) {
  const int tid = threadIdx.x;
  const int nq = it & 7, part = (it >> 3) & 1, g = (it >> 4) & 7, j = it >> 7;
  if (tid < 128) { const float f = (float)tid * (1.0f / 128.0f); trig[tid] = __builtin_amdgcn_cosf(f); trig[128 + tid] = __builtin_amdgcn_sinf(f); }
  __syncthreads();
  const int co = tid >> 5, c0 = co * 8;
  const float sc = 0.08838834764831845f;
  {
    const int n = nq * 128 + (tid & 31) * 4;
    const float* W = p.w_out_f + (size_t)j * 1048576 + (size_t)(g * 128) * 1024 + n;
    f32x4 acc[8];
#pragma unroll
    for (int e = 0; e < 8; ++e) acc[e] = (f32x4){0.f, 0.f, 0.f, 0.f};
#pragma unroll 8
    for (int kc = 0; kc < 128; ++kc) {
      const f32x4 w = *(const f32x4*)(W + (size_t)kc * 1024);
#pragma unroll
      for (int e = 0; e < 8; ++e) acc[e] += w * trig[part * 128 + (((c0 + e) * kc) & 127)];
    }
    bf16_t* dst = (bf16_t*)(p.ws + WS_W12) + (size_t)j * 2097152 + (size_t)(part * 1024 + n) * 1024 + g * 128 + c0;
#pragma unroll
    for (int q = 0; q < 4; ++q) {
      u32x4 o; o.x = pk2(acc[0][q] * sc, acc[1][q] * sc); o.y = pk2(acc[2][q] * sc, acc[3][q] * sc); o.z = pk2(acc[4][q] * sc, acc[5][q] * sc); o.w = pk2(acc[6][q] * sc, acc[7][q] * sc);
      *(u32x4*)(dst + (size_t)q * 1024) = o;
    }
  }
  __syncthreads();
}

DI void dn256_item(bf16_t* Dn, int it, float sgn, float scale) {
  const int idx0 = it * 512 + threadIdx.x, k = idx0 >> 6, col0 = (idx0 & 63) * 8, half = col0 >> 8, n0 = col0 & 255;
  float v[8];
#pragma unroll
  for (int e = 0; e < 8; ++e) {
    const int idx = (k * (n0 + e)) & 255; const float f = (float)idx * (1.0f / 256.0f);
    v[e] = (half ? sgn * __builtin_amdgcn_sinf(f) : __builtin_amdgcn_cosf(f)) * scale;
  }
  u32x4 o; o.x = pk2(v[0], v[1]); o.y = pk2(v[2], v[3]); o.z = pk2(v[4], v[5]); o.w = pk2(v[6], v[7]);
  *(u32x4*)(Dn + (size_t)k * 512 + col0) = o;
}
DI void rope_item(float* tab) {
#pragma unroll
  for (int i = 0; i < 2; ++i) {
    const int e = threadIdx.x + 512 * i, pos = e >> 4, fi = e & 15;
    const float inv = __builtin_amdgcn_exp2f(-(float)fi * (13.287712379549449f / 16.0f));
    const float ang = (float)pos * inv; float rev = ang * 0.15915494309189535f; rev = rev - floorf(rev);
    tab[e] = __builtin_amdgcn_cosf(rev); tab[1024 + e] = __builtin_amdgcn_sinf(rev);
  }
}
DI void modp_item(LAS float* sm, const Params& p, int it) {
  const int tid = threadIdx.x, layer = it / 192, rem = it % 192, cb = rem / 32, kc = rem % 32;
  LAS float* scv = sm;
  LAS float* red = sm + 160;
  if (tid < 160) { const int cond = tid >> 5, kk = tid & 31, k = kc * 32 + kk; const float v = cond < 4 ? p.c[cond * 1024 + k] : p.c_ctx[k];
    scv[tid] = v / (1.0f + __builtin_amdgcn_exp2f(-v * 1.4426950408889634f)); }
  __syncthreads();
  const int c4 = tid & 255, kh = tid >> 8;
  f32x4 acc[5];
#pragma unroll
  for (int cnd = 0; cnd < 5; ++cnd) acc[cnd] = (f32x4){0.f, 0.f, 0.f, 0.f};
  const float* wp = p.ada_w + ((size_t)layer * 1024 + kc * 32 + kh * 16) * 6144 + cb * 1024 + c4 * 4;
  f32x4 w[16];
#pragma unroll
  for (int kk = 0; kk < 16; ++kk) w[kk] = *(const f32x4*)(wp + (size_t)kk * 6144);
#pragma unroll
  for (int kk = 0; kk < 16; ++kk)
#pragma unroll
    for (int cnd = 0; cnd < 5; ++cnd) acc[cnd] += w[kk] * scv[cnd * 32 + kh * 16 + kk];
  if (kh == 1) {
#pragma unroll
    for (int cnd = 0; cnd < 5; ++cnd) *(LAS f32x4*)(red + (cnd * 256 + c4) * 4) = acc[cnd];
  }
  __syncthreads();
  if (kh == 0) {
    float* mp = (float*)(p.ws + WS_MODP);
#pragma unroll
    for (int cnd = 0; cnd < 5; ++cnd) {
      const f32x4 o = acc[cnd] + *(const LAS f32x4*)(red + (cnd * 256 + c4) * 4);
      *(f32x4*)(mp + ((size_t)((kc * 4 + layer) * 5 + cnd)) * 6144 + cb * 1024 + c4 * 4) = o;
    }
  }
  __syncthreads();
}

DI void phase0(LAS unsigned char* lds, const Params& p) {
  LAS float* smf = (LAS float*)lds;
  constexpr int N_TR = 2560, N_W12 = 256, N_DN = 32, N_D256 = 32, N_ROPE = 1, N_MODP = 768;
  constexpr int TOT = N_TR + N_W12 + N_DN + N_D256 + N_ROPE + N_MODP;
  for (int it = blockIdx.x; it < TOT; it += gridDim.x) {
    int i = it;
    if (i < N_MODP) { modp_item(smf, p, i); continue; }
    i -= N_MODP;
    if (i < N_W12) { w12_item(smf, p, i); continue; }
    i -= N_W12;
    if (i < N_TR) {
      if (i < 384) { const int j = i / 192, rem = i % 192; tr_item(smf, p.w_in + (size_t)j * 3145728, (bf16_t*)(p.ws + WS_WIN) + (size_t)j * 3145728, 1024, 3072, rem / 12, rem % 12); }
      else if (i < 1408) { const int q = i - 384, l = q / 256, rem = q % 256; tr_item(smf, p.w1 + (size_t)l * 4194304, (bf16_t*)(p.ws + WS_W1) + (size_t)l * 4194304, 1024, 4096, rem / 16, rem % 16); }
      else if (i < 2432) { const int q = i - 1408, l = q / 256, rem = q % 256; tr_item(smf, p.w2 + (size_t)l * 4194304, (bf16_t*)(p.ws + WS_W2) + (size_t)l * 4194304, 4096, 1024, rem / 4, rem % 4); }
      else { const int q = i - 2432, j = q / 64, rem = q % 64; tr_item(smf, p.w_out_mix + (size_t)j * 1048576, (bf16_t*)(p.ws + WS_WOM) + (size_t)j * 1048576, 1024, 1024, rem / 4, rem % 4); }
      continue;
    }
    i -= N_TR;
    if (i < N_DN) { dn256_item((bf16_t*)(p.ws + WS_DN2), i, 1.0f, 1.0f / 64.0f); continue; }
    i -= N_DN;
    if (i < N_D256) { dn256_item((bf16_t*)(p.ws + WS_DN256), i, -1.0f, 1.0f / 16.0f); continue; }
    rope_item((float*)(p.ws + WS_ROPE));
  }
}

DI void phase0b(const Params& p) {
  const float* mp = (const float*)(p.ws + WS_MODP); float* mod = (float*)(p.ws + WS_MOD);
  for (int i = blockIdx.x * 512 + threadIdx.x; i < 30720; i += gridDim.x * 512) {
    const int e = i * 4, layer = e / 30720, col = e % 6144;
    f32x4 a = *(const f32x4*)(p.ada_b + layer * 6144 + col);
#pragma unroll
    for (int kc = 0; kc < 32; ++kc) a += *(const f32x4*)(mp + (size_t)kc * 122880 + e);
    *(f32x4*)(mod + e) = a;
  }
}

DI void ln_pass(const Params& p, bool first, const float* gate, const float* lng, const float* lnb, const float* nsh, const float* nsc, bool last, bool lat_only, int nks) {
  int tid = threadIdx.x; asm volatile("" : "+v"(tid));
  const int wave = tid >> 6, lane = tid & 63;
  float* H = (float*)(p.ws + WS_H); const bf16_t* Y = (const bf16_t*)(p.ws + WS_Y); bf16_t* U = (bf16_t*)(p.ws + WS_U);
  const int npairs = (lat_only ? 16384 : NROW) / 2;
  for (int pi = blockIdx.x * 8 + wave; pi < npairs; pi += gridDim.x * 8) {
    const int rv = pi * 2;
    int b, t;
    if (lat_only) { b = rv >> 12; t = rv & 4095; } else { b = rv / TPB; t = rv % TPB; }
    const size_t r = (size_t)b * TPB + t; const int cond = t < 4096 ? b : 4;
    float v[2][16];
    if (first) {
      const float* src = t < 4096 ? p.x + ((size_t)(b * 4096 + t)) * 1024 : p.ctx + ((size_t)(b * 256 + t - 4096)) * 1024;
#pragma unroll
      for (int z = 0; z < 2; ++z)
#pragma unroll
        for (int q = 0; q < 4; ++q) { const f32x4 a = *(const f32x4*)(src + z * 1024 + q * 256 + lane * 4); v[z][4 * q] = a[0]; v[z][4 * q + 1] = a[1]; v[z][4 * q + 2] = a[2]; v[z][4 * q + 3] = a[3]; }
    } else {
      const float* hr = H + r * 1024; const bf16_t* yr = Y + r * 1024; const float* gr = gate + cond * 6144;
      f32x4 ha[2][4]; f32x4 yv[2][4];
#pragma unroll
      for (int z = 0; z < 2; ++z)
#pragma unroll
        for (int q = 0; q < 4; ++q) { const int c = z * 1024 + q * 256 + lane * 4; ha[z][q] = *(const f32x4*)(hr + c); }
      if (nks > 0 && t >= 4096) {
        const bf16_t* pr = (const bf16_t*)p.out + ((size_t)(b * 256 + t - 4096)) * 1024;
#pragma unroll
        for (int z = 0; z < 2; ++z)
#pragma unroll
          for (int q = 0; q < 4; ++q) yv[z][q] = (f32x4){0.f, 0.f, 0.f, 0.f};
        for (int ks = 0; ks < nks; ++ks) {
#pragma unroll
          for (int z = 0; z < 2; ++z)
#pragma unroll
            for (int q = 0; q < 4; ++q) { const u32x2 w = *(const u32x2*)(pr + (size_t)ks * 1048576 + z * 1024 + q * 256 + lane * 4);
              yv[z][q][0] += bflo(w.x); yv[z][q][1] += bfhi(w.x); yv[z][q][2] += bflo(w.y); yv[z][q][3] += bfhi(w.y); }
        }
      } else {
#pragma unroll
        for (int z = 0; z < 2; ++z)
#pragma unroll
          for (int q = 0; q < 4; ++q) { const u32x2 w = *(const u32x2*)(yr + z * 1024 + q * 256 + lane * 4); yv[z][q] = (f32x4){bflo(w.x), bfhi(w.x), bflo(w.y), bfhi(w.y)}; }
      }
      float s[2] = {0.f, 0.f};
#pragma unroll
      for (int q = 0; q < 4; ++q) {
        const f32x4 g = *(const f32x4*)(gr + q * 256 + lane * 4);
#pragma unroll
        for (int z = 0; z < 2; ++z) {
#pragma unroll
          for (int e = 0; e < 4; ++e) v[z][4 * q + e] = ALPHA * ha[z][q][e] + g[e] * yv[z][q][e];
          s[z] += v[z][4 * q] + v[z][4 * q + 1] + v[z][4 * q + 2] + v[z][4 * q + 3];
        }
      }
      float mu[2], rstd[2];
#pragma unroll
      for (int z = 0; z < 2; ++z) mu[z] = wave_sum(s[z]) * (1.0f / 1024.0f);
#pragma unroll
      for (int z = 0; z < 2; ++z) { float ss = 0.f;
#pragma unroll
        for (int e = 0; e < 16; ++e) { const float d = v[z][e] - mu[z]; ss += d * d; }
        s[z] = ss; }
#pragma unroll
      for (int z = 0; z < 2; ++z) rstd[z] = __builtin_amdgcn_rsqf(wave_sum(s[z]) * (1.0f / 1024.0f) + 1e-6f);
#pragma unroll
      for (int q = 0; q < 4; ++q) {
        const int c = q * 256 + lane * 4;
        const f32x4 g = *(const f32x4*)(lng + c), bb = *(const f32x4*)(lnb + c);
#pragma unroll
        for (int z = 0; z < 2; ++z)
#pragma unroll
          for (int e = 0; e < 4; ++e) v[z][4 * q + e] = (v[z][4 * q + e] - mu[z]) * rstd[z] * g[e] + bb[e];
      }
    }
    float* dst = last ? p.out + ((size_t)(b * 4096 + t)) * 1024 : H + r * 1024;
#pragma unroll
    for (int z = 0; z < 2; ++z)
#pragma unroll
      for (int q = 0; q < 4; ++q) *(f32x4*)(dst + z * 1024 + q * 256 + lane * 4) = (f32x4){v[z][4 * q], v[z][4 * q + 1], v[z][4 * q + 2], v[z][4 * q + 3]};
    if (!last) {
      float s[2], mu[2], rstd[2];
#pragma unroll
      for (int z = 0; z < 2; ++z) { float a = 0.f;
#pragma unroll
        for (int e = 0; e < 16; ++e) a += v[z][e];
        s[z] = a; }
#pragma unroll
      for (int z = 0; z < 2; ++z) mu[z] = wave_sum(s[z]) * (1.0f / 1024.0f);
#pragma unroll
      for (int z = 0; z < 2; ++z) { float ss = 0.f;
#pragma unroll
        for (int e = 0; e < 16; ++e) { const float d = v[z][e] - mu[z]; ss += d * d; }
        s[z] = ss; }
#pragma unroll
      for (int z = 0; z < 2; ++z) rstd[z] = __builtin_amdgcn_rsqf(wave_sum(s[z]) * (1.0f / 1024.0f) + 1e-6f);
      const float* shr = nsh + cond * 6144; const float* scr = nsc + cond * 6144;
#pragma unroll
      for (int q = 0; q < 4; ++q) {
        const int c = q * 256 + lane * 4;
        const f32x4 sh = *(const f32x4*)(shr + c), sc = *(const f32x4*)(scr + c);
#pragma unroll
        for (int z = 0; z < 2; ++z) {
          float o[4];
#pragma unroll
          for (int e = 0; e < 4; ++e) o[e] = (v[z][4 * q + e] - mu[z]) * rstd[z] * (1.0f + sc[e]) + sh[e];
          u32x2 w; w.x = pk2(o[0], o[1]); w.y = pk2(o[2], o[3]);
          *(u32x2*)(U + (r + z) * 1024 + c) = w;
        }
      }
    }
  }
}


DI void dft4(float& r0, float& i0, float& r1, float& i1, float& r2, float& i2, float& r3, float& i3) {
  const float t0r = r0 + r2, t0i = i0 + i2, t1r = r0 - r2, t1i = i0 - i2, t2r = r1 + r3, t2i = i1 + i3, t3r = r1 - r3, t3i = i1 - i3;
  r0 = t0r + t2r; i0 = t0i + t2i; r2 = t0r - t2r; i2 = t0i - t2i;
  r1 = t1r + t3i; i1 = t1i - t3r; r3 = t1r - t3i; i3 = t1i + t3r;
}
DI void fft16_pass(const Params& p) {
  int tid = threadIdx.x; asm volatile("" : "+v"(tid));
  const bf16_t* Zt = (const bf16_t*)(p.ws + WS_ZT); bf16_t* Wt = (bf16_t*)(p.ws + WS_WT);
  const int sub = tid >> 7, np = tid & 127, n1 = np * 2;
  for (int it = blockIdx.x; it < 1024; it += gridDim.x) {
    const int bc = it * 4 + sub, b = bc >> 10, ch = bc & 1023;
    const bf16_t* zr = Zt + (size_t)bc * 8192 + n1;
    unsigned ga[16], gb[16];
#pragma unroll
    for (int n2 = 0; n2 < 16; ++n2) { ga[n2] = *(const unsigned*)(zr + 256 * n2); gb[n2] = *(const unsigned*)(zr + 4096 + 256 * n2); }
    float outr[2][16], outi[2][16];
#pragma unroll
    for (int z = 0; z < 2; ++z) {
      float xr[16], xi[16];
#pragma unroll
      for (int n2 = 0; n2 < 16; ++n2) { xr[n2] = z ? bfhi(ga[n2]) : bflo(ga[n2]); xi[n2] = -(z ? bfhi(gb[n2]) : bflo(gb[n2])); }
#pragma unroll
      for (int bb = 0; bb < 4; ++bb) dft4(xr[bb], xi[bb], xr[4 + bb], xi[4 + bb], xr[8 + bb], xi[8 + bb], xr[12 + bb], xi[12 + bb]);
#pragma unroll
      for (int c = 1; c < 4; ++c)
#pragma unroll
        for (int bb = 1; bb < 4; ++bb) {
          const int m = bb * c;
          const float cw = (m == 1) ? 0.9238795325112867f : (m == 2) ? 0.7071067811865476f : (m == 3) ? 0.3826834323650898f : (m == 4) ? 0.f : (m == 6) ? -0.7071067811865476f : -0.9238795325112867f;
          const float sw = (m == 1) ? 0.3826834323650898f : (m == 2) ? 0.7071067811865476f : (m == 3) ? 0.9238795325112867f : (m == 4) ? 1.f : (m == 6) ? 0.7071067811865476f : -0.3826834323650898f;
          const float a = xr[4 * c + bb], bq = xi[4 * c + bb];
          xr[4 * c + bb] = a * cw + bq * sw; xi[4 * c + bb] = bq * cw - a * sw;
        }
#pragma unroll
      for (int c = 0; c < 4; ++c) dft4(xr[4 * c], xi[4 * c], xr[4 * c + 1], xi[4 * c + 1], xr[4 * c + 2], xi[4 * c + 2], xr[4 * c + 3], xi[4 * c + 3]);
#pragma unroll
      for (int c = 0; c < 4; ++c)
#pragma unroll
        for (int d = 0; d < 4; ++d) {
          const int k2 = c + 4 * d;
          const float f = (float)(k2 * (n1 + z)) * (1.0f / 4096.0f);
          const float cw = __builtin_amdgcn_cosf(f), sw = __builtin_amdgcn_sinf(f);
          const float a = xr[4 * c + d], bq = xi[4 * c + d];
          outr[z][k2] = a * cw + bq * sw; outi[z][k2] = bq * cw - a * sw;
        }
    }
    bf16_t* wr0 = Wt + ((size_t)(b * 16) * 1024 + ch) * 512 + n1;
#pragma unroll
    for (int k2 = 0; k2 < 16; ++k2) {
      bf16_t* wp = wr0 + (size_t)k2 * (1024 * 512);
      *(unsigned*)wp = pk2(outr[0][k2], outr[1][k2]);
      *(unsigned*)(wp + 256) = pk2(outi[0][k2], outi[1][k2]);
    }
  }
}

#define MFMA32(a, b, c) __builtin_amdgcn_mfma_f32_32x32x16_bf16((a), (b), (c), 0, 0, 0)
constexpr int ATT_BUF = 35840, ATT_KC = 9216, ATT_V = 18432;

DI void attn_item(LAS unsigned char* lds, const Params& p, int b, int head, int t0, int kt0, int kt1, float lam, float oscale, const float* subg) {
  int tid = threadIdx.x; asm volatile("" : "+v"(tid));
  const int wid = tid >> 6, lane = tid & 63, r = lane & 31, h = lane >> 5, comp = wid >> 2, wq = wid & 3;
  const bf16_t* Qb = (const bf16_t*)(p.ws + WS_QB); const bf16_t* Kb = (const bf16_t*)(p.ws + WS_KB); const bf16_t* Vt = (const bf16_t*)(p.ws + WS_VT);
  bf16_t* mix = (bf16_t*)(p.ws + WS_MIX);
  const size_t qrow = (size_t)b * TPB + t0 + wq * 32 + r;
  bf16x8 qf[4];
  { const bf16_t* qp = Qb + qrow * 512 + head * 128 + comp * 64 + 8 * h;
#pragma unroll
    for (int s = 0; s < 4; ++s) qf[s] = *(const bf16x8*)(qp + 16 * s); }
  f32x16 o[4];
#pragma unroll
  for (int k = 0; k < 4; ++k)
#pragma unroll
    for (int i = 0; i < 16; ++i) o[k][i] = 0.f;
  float mrun = -1e30f, lrun = 0.f;
  const float sc = 0.125f * 1.4426950408889634f;
  const char* kg = (const char*)Kb + ((size_t)((b * 4 + head) * 2) * TPB) * 128;
  const char* vg = (const char*)Vt + ((size_t)((b * 4 + head) * 128)) * TPB * 2;
  const unsigned koff[2] = {(unsigned)tid * 16u, (unsigned)tid * 16u + (unsigned)(TPB * 128)};
  const unsigned voff[2] = {(unsigned)(tid >> 3) * (unsigned)(TPB * 2) + (unsigned)(tid & 7) * 16u, (unsigned)((tid >> 3) + 64) * (unsigned)(TPB * 2) + (unsigned)(tid & 7) * 16u};
  const unsigned kl = (unsigned)((tid >> 3) * 144 + (tid & 7) * 16);
  const unsigned vl = (unsigned)(ATT_V + (tid >> 3) * 136 + (tid & 7) * 16);
  u32x4 kr[2], vr[2];
#define ATT_LOAD(kt) do { _Pragma("unroll") for (int i = 0; i < 2; ++i) { \
    kr[i] = *(const u32x4*)(kg + (size_t)(kt) * 8192 + koff[i]); \
    vr[i] = *(const u32x4*)(vg + (size_t)(kt) * 128 + voff[i]); } } while (0)
#define ATT_STORE(buf) do { _Pragma("unroll") for (int i = 0; i < 2; ++i) { \
    *(LAS u32x4*)(lds + (buf) * ATT_BUF + i * ATT_KC + kl) = kr[i]; \
    *(LAS u32x2*)(lds + (buf) * ATT_BUF + i * (64 * 136) + vl) = (u32x2){vr[i].x, vr[i].y}; \
    *(LAS u32x2*)(lds + (buf) * ATT_BUF + i * (64 * 136) + vl + 8) = (u32x2){vr[i].z, vr[i].w}; } } while (0)
  ATT_LOAD(kt0);
  ATT_STORE(0);
  __syncthreads();
  int buf = 0;
  for (int kt = kt0; kt < kt1; ++kt) {
    const bool more = (kt + 1 < kt1);
    if (more) ATT_LOAD(kt + 1);
    const LAS unsigned char* ks = lds + buf * ATT_BUF + comp * ATT_KC + r * 144 + h * 16;
    const LAS unsigned char* vs = lds + buf * ATT_BUF + ATT_V + r * 136 + h * 8;
    bf16x8 kf[8];
#pragma unroll
    for (int kb = 0; kb < 2; ++kb)
#pragma unroll
      for (int s = 0; s < 4; ++s) kf[kb * 4 + s] = *(const LAS bf16x8*)(ks + kb * 4608 + s * 32);
    __builtin_amdgcn_sched_barrier(0);
    f32x16 x[2];
#pragma unroll
    for (int kb = 0; kb < 2; ++kb) {
#pragma unroll
      for (int i = 0; i < 16; ++i) x[kb][i] = 0.f;
#pragma unroll
      for (int s = 0; s < 4; ++s) x[kb] = MFMA32(kf[kb * 4 + s], qf[s], x[kb]);
    }
    s16x4 vlo[8], vhi[8];
#pragma unroll
    for (int s2 = 0; s2 < 2; ++s2)
#pragma unroll
      for (int blk = 0; blk < 4; ++blk) {
        vlo[s2 * 4 + blk] = *(const LAS s16x4*)(vs + blk * 4352 + s2 * 32);
        vhi[s2 * 4 + blk] = *(const LAS s16x4*)(vs + blk * 4352 + s2 * 32 + 16);
      }
    __builtin_amdgcn_sched_barrier(0);
    float mx = x[0][0];
#pragma unroll
    for (int kb = 0; kb < 2; ++kb)
#pragma unroll
      for (int i = 0; i < 16; ++i) mx = fmaxf(mx, x[kb][i]);
    mx = fmaxf(mx, __shfl_xor(mx, 32));
    const float mxs = mx * sc;
    const bool need = mxs > mrun + 8.0f;
    if (__builtin_amdgcn_ballot_w64(need) != 0ull) {
      const float mnew = need ? mxs : mrun;
      const float alpha = __builtin_amdgcn_exp2f(mrun - mnew);
      mrun = mnew; lrun *= alpha;
#pragma unroll
      for (int k = 0; k < 4; ++k)
#pragma unroll
        for (int i = 0; i < 16; ++i) o[k][i] *= alpha;
    }
    float ps = 0.f;
#pragma unroll
    for (int kb = 0; kb < 2; ++kb)
#pragma unroll
      for (int i = 0; i < 16; ++i) { const float e = __builtin_amdgcn_exp2f(x[kb][i] * sc - mrun); x[kb][i] = e; ps += e; }
    lrun += ps;
#pragma unroll
    for (int kb = 0; kb < 2; ++kb) {
      bf16x8 pb[2];
#pragma unroll
      for (int s2 = 0; s2 < 2; ++s2) {
        u32x4 pw; pw.x = pk2(x[kb][8 * s2], x[kb][8 * s2 + 1]); pw.y = pk2(x[kb][8 * s2 + 2], x[kb][8 * s2 + 3]);
        pw.z = pk2(x[kb][8 * s2 + 4], x[kb][8 * s2 + 5]); pw.w = pk2(x[kb][8 * s2 + 6], x[kb][8 * s2 + 7]);
        pb[s2] = __builtin_bit_cast(bf16x8, pw);
      }
#pragma unroll
      for (int s2 = 0; s2 < 2; ++s2)
#pragma unroll
        for (int blk = 0; blk < 4; ++blk) {
          const bf16x8 a = __builtin_shufflevector(vlo[s2 * 4 + blk], vhi[s2 * 4 + blk], 0, 1, 2, 3, 4, 5, 6, 7);
          o[blk] = MFMA32(a, pb[s2], o[blk]);
        }
      if (kb == 0) {
        __builtin_amdgcn_sched_barrier(0);
#pragma unroll
        for (int s2 = 0; s2 < 2; ++s2)
#pragma unroll
          for (int blk = 0; blk < 4; ++blk) {
            vlo[s2 * 4 + blk] = *(const LAS s16x4*)(vs + blk * 4352 + 64 + s2 * 32);
            vhi[s2 * 4 + blk] = *(const LAS s16x4*)(vs + blk * 4352 + 64 + s2 * 32 + 16);
          }
      }
    }
    if (more) ATT_STORE(buf ^ 1);
    __syncthreads();
    buf ^= 1;
  }
#undef ATT_LOAD
#undef ATT_STORE
  const float ltot = lrun + __shfl_xor(lrun, 32);
  const float inv = 1.0f / ltot;
  LAS float* cmb = (LAS float*)lds;
  if (comp == 1) {
#pragma unroll
    for (int k = 0; k < 4; ++k)
#pragma unroll
      for (int i = 0; i < 16; ++i) cmb[(wq * 64 + k * 16 + i) * 64 + lane] = o[k][i] * inv;
  }
  __syncthreads();
  if (comp == 0) {
    float ss = 0.f;
#pragma unroll
    for (int k = 0; k < 4; ++k)
#pragma unroll
      for (int i = 0; i < 16; ++i) { const float d = o[k][i] * inv - lam * cmb[(wq * 64 + k * 16 + i) * 64 + lane]; o[k][i] = d; ss += d * d; }
    ss += __shfl_xor(ss, 32);
    const float rn = __builtin_amdgcn_rsqf(ss * (1.0f / 128.0f) + 1e-5f) * oscale;
    bf16_t* dst = mix + qrow * 1024 + 512 + head * 128;
#pragma unroll
    for (int k = 0; k < 4; ++k)
#pragma unroll
      for (int g4 = 0; g4 < 4; ++g4) {
        const int dv = 32 * k + 8 * g4 + 4 * h;
        const f32x4 gg = *(const f32x4*)(subg + dv);
        u32x2 w; w.x = pk2(o[k][4 * g4] * rn * gg[0], o[k][4 * g4 + 1] * rn * gg[1]); w.y = pk2(o[k][4 * g4 + 2] * rn * gg[2], o[k][4 * g4 + 3] * rn * gg[3]);
        *(u32x2*)(dst + dv) = w;
      }
  }
  __syncthreads();
}

DI void conv_item(const Params& p, int ci, const float* cw) {
  int tid = threadIdx.x; asm volatile("" : "+v"(tid));
  const int cg8 = tid & 63, rr = tid >> 6, c0 = cg8 * 8;
  const bf16_t* P = (const bf16_t*)(p.ws + WS_P); bf16_t* mix = (bf16_t*)(p.ws + WS_MIX);
  float w0[8], w1[8], w2[8];
#pragma unroll
  for (int e = 0; e < 8; ++e) { w0[e] = cw[c0 + e]; w1[e] = cw[512 + c0 + e]; w2[e] = cw[1024 + c0 + e]; }
#pragma unroll 1
  for (int q = 0; q < 4; ++q) {
    const int r = ci * 32 + rr + 8 * q, t = r % TPB;
    const bf16_t* pr = P + (size_t)r * 1536 + c0;
    const u32x4 gb = *(const u32x4*)pr;
    const u32x4 gc1 = *(const u32x4*)(pr + 512), v1 = *(const u32x4*)(pr + 1024);
    u32x4 gc0 = (u32x4){0, 0, 0, 0}, v0 = gc0, gc2 = gc0, v2 = gc0;
    if (t != 0 && t != 4096) { gc0 = *(const u32x4*)(pr - 1536 + 512); v0 = *(const u32x4*)(pr - 1536 + 1024); }
    if (t != 4095 && t != 4351) { gc2 = *(const u32x4*)(pr + 1536 + 512); v2 = *(const u32x4*)(pr + 1536 + 1024); }
    float o[8];
#pragma unroll
    for (int e2 = 0; e2 < 4; ++e2) {
      const float a0 = bflo(gc0[e2]) * bflo(v0[e2]), a1 = bflo(gc1[e2]) * bflo(v1[e2]), a2 = bflo(gc2[e2]) * bflo(v2[e2]);
      const float b0 = bfhi(gc0[e2]) * bfhi(v0[e2]), b1 = bfhi(gc1[e2]) * bfhi(v1[e2]), b2 = bfhi(gc2[e2]) * bfhi(v2[e2]);
      o[2 * e2] = bflo(gb[e2]) * (w0[2 * e2] * a0 + w1[2 * e2] * a1 + w2[2 * e2] * a2);
      o[2 * e2 + 1] = bfhi(gb[e2]) * (w0[2 * e2 + 1] * b0 + w1[2 * e2 + 1] * b1 + w2[2 * e2 + 1] * b2);
    }
    u32x4 w; w.x = pk2(o[0], o[1]); w.y = pk2(o[2], o[3]); w.z = pk2(o[4], o[5]); w.w = pk2(o[6], o[7]);
    *(u32x4*)(mix + (size_t)r * 1024 + c0) = w;
  }
}

DI void attn_phase(LAS unsigned char* lds, const Params& p, int layer) {
  int tid0 = threadIdx.x; asm volatile("" : "+v"(tid0));
  const int j = layer >> 1, lane = tid0 & 63;
  const float lam_init = (layer == 0) ? 0.2f : 0.47071301834382377f;
  const float* lq = p.lam_qk + j * 256;
  const float sa = wave_sum(lq[lane] * lq[64 + lane]), sb = wave_sum(lq[128 + lane] * lq[192 + lane]);
  const float lam = __builtin_amdgcn_exp2f(sa * 1.4426950408889634f) - __builtin_amdgcn_exp2f(sb * 1.4426950408889634f) + lam_init;
  const float oscale = 1.0f - lam_init;
  const float* subg = p.subln_g + j * 128;
  const float* cw = p.conv_w + j * 1536;
  const int natt = 512 + (layer == 0 ? 32 : 0), total = natt + 544;
  for (int it = blockIdx.x; it < total; it += gridDim.x) {
    if (it < 512) {
      const int round = it >> 8, c = it & 255, pair = round * 8 + (c & 7), qblk = c >> 3;
      attn_item(lds, p, pair >> 2, pair & 3, qblk * 128, 0, 68, lam, oscale, subg);
    } else if (it < natt) {
      const int c = it - 512;
      attn_item(lds, p, c >> 3, (c >> 1) & 3, 4096 + (c & 1) * 128, 64, 68, lam, oscale, subg);
    } else conv_item(p, it - natt, cw);
  }
}

__global__ void __launch_bounds__(512, 2) fwd_megakernel(Params p) {
  extern __shared__ __attribute__((aligned(16))) unsigned char shm[];
  LAS unsigned char* lds = (LAS unsigned char*)shm;
  cg::grid_group grid = cg::this_grid();
  unsigned char* ws = p.ws;
  const float* mod = (const float*)(ws + WS_MOD);
  bf16_t* U = (bf16_t*)(ws + WS_U); bf16_t* Y = (bf16_t*)(ws + WS_Y);

  unsigned* bar = (unsigned*)(ws + WS_BAR);
  volatile LAS unsigned* xst = (volatile LAS unsigned*)(lds + 131072);
  if (blockIdx.x == 0) for (int i = threadIdx.x; i < XCD_BAR_WORDS; i += 512) __hip_atomic_store(&bar[i], 0u, __ATOMIC_RELAXED, __HIP_MEMORY_SCOPE_AGENT);
  if (threadIdx.x == 0) { xst[0] = 0u; xst[1] = 0u; }
  __syncthreads();
  for (int rep = 0; rep < REP_P0; ++rep) { phase0(lds, p); __syncthreads(); }
  grid.sync();
  const XcdBarrier xb = xcd_barrier_post(bar, xst);
#define GSYNC() xcd_barrier(xb)
  phase0b(p);
  GSYNC();
  ln_pass(p, true, nullptr, nullptr, nullptr, mod + 0, mod + 1024, false, false, 0);
  GSYNC();

  bf16_t* PART = (bf16_t*)p.out;
  for (int layer = 0; layer < 4; ++layer) {
    const int j = layer >> 1;
    const float* lmod = mod + (size_t)layer * 30720;
    const bool ctx_alive = layer < 2;
    int nks_mid = 0;
    if ((layer & 1) == 0) {
      { Gemm g{U, (const bf16_t*)(ws + WS_WIN) + (size_t)j * 3145728, NROW, 2560, 1024, 0, 1, 0, 1024, 1024};
        Epi<EP_QKC> e{(bf16_t*)(ws + WS_P), (bf16_t*)(ws + WS_QB), (bf16_t*)(ws + WS_KB), (const float*)(ws + WS_ROPE), (const float*)(ws + WS_ROPE) + 1024, 0, 0, 0};
        for (int rep = 0; rep < REP_GEMM * REP_E1A; ++rep) gemm_phase(lds, g, e); }
      { Gemm g{(const bf16_t*)(ws + WS_WIN) + (size_t)j * 3145728 + (size_t)2560 * 1024, U, 512, NROW, 1024, 0, 1, 0, 1024, 1024};
        Epi<EP_VT> e{(bf16_t*)(ws + WS_VT), nullptr, nullptr, nullptr, nullptr, 0, 0, 0};
        for (int rep = 0; rep < REP_GEMM * REP_E1V; ++rep) gemm_phase(lds, g, e); }
      GSYNC();
      for (int rep = 0; rep < REP_ATT; ++rep) attn_phase(lds, p, layer);
      GSYNC();
      { Gemm g{(const bf16_t*)(ws + WS_MIX), (const bf16_t*)(ws + WS_WOM) + (size_t)j * 1048576, 16384, 1024, 1024, 1, 1, 0, 1024, 1024};
        Epi<EP_PLAIN> e{Y, nullptr, nullptr, nullptr, nullptr, 1024, 0, 0};
        for (int rep = 0; rep < REP_GEMM * REP_E3L; ++rep) gemm_phase(lds, g, e); }
      if (ctx_alive) {
        Gemm g{(const bf16_t*)(ws + WS_MIX), (const bf16_t*)(ws + WS_WOM) + (size_t)j * 1048576, 4096, 1024, 256, 4, 4, 0, 1024, 1024};
        Epi<EP_PLAIN> e{PART, nullptr, nullptr, nullptr, nullptr, 1024, 4, 4};
        for (int rep = 0; rep < REP_GEMM * REP_E3C; ++rep) gemm_phase(lds, g, e);
        nks_mid = 4;
      }
      GSYNC();
    } else {
      { Gemm g{(const bf16_t*)(ws + WS_W12) + (size_t)j * 2097152, U, 2048, ctx_alive ? NROW : 16384, 1024, ctx_alive ? 0 : 2, 1, 0, 1024, 1024};
        Epi<EP_ZT> e{(bf16_t*)(ws + WS_ZT), (bf16_t*)(ws + WS_ZTC), nullptr, nullptr, nullptr, 0, 0, 0};
        for (int rep = 0; rep < REP_GEMM * REP_O1; ++rep) gemm_phase(lds, g, e); }
      GSYNC();
      fft16_pass(p);
      GSYNC();
      { Gemm g{(const bf16_t*)(ws + WS_DN2), (const bf16_t*)(ws + WS_WT), 16384, 1024, 512, 3, 1, (size_t)1024 * 512 * 2, 512, 512};
        Epi<EP_PLAIN> e{Y, nullptr, nullptr, nullptr, nullptr, 1024, 3, 0};
        for (int rep = 0; rep < REP_GEMM * REP_O2L; ++rep) gemm_phase(lds, g, e); }
      if (ctx_alive) {
        Gemm g{(const bf16_t*)(ws + WS_DN256), (const bf16_t*)(ws + WS_ZTC), 1024, 1024, 512, 3, 1, (size_t)1024 * 512 * 2, 512, 512};
        Epi<EP_PLAIN> e{Y, nullptr, nullptr, nullptr, nullptr, 1024, 2, 0};
        for (int rep = 0; rep < REP_GEMM * REP_O2C; ++rep) gemm_phase(lds, g, e);
      }
      GSYNC();
    }
    ln_pass(p, false, lmod + 2048, p.ln_g + (size_t)(layer * 2) * 1024, p.ln_b + (size_t)(layer * 2) * 1024, lmod + 3072, lmod + 4096, false, !ctx_alive, nks_mid);
    GSYNC();
    { Gemm g{U, (const bf16_t*)(ws + WS_W1) + (size_t)layer * 4194304, ctx_alive ? NROW : 16384, 4096, 1024, ctx_alive ? 0 : 1, 1, 0, 1024, 1024};
      Epi<EP_RELU2> e{(bf16_t*)(ws + WS_HID), nullptr, nullptr, nullptr, nullptr, 4096, 0, 0};
      for (int rep = 0; rep < REP_GEMM * REP_M1; ++rep) gemm_phase(lds, g, e); }
    GSYNC();
    { Gemm g{(const bf16_t*)(ws + WS_HID), (const bf16_t*)(ws + WS_W2) + (size_t)layer * 4194304, 16384, 1024, 4096, 1, 1, 0, 4096, 4096};
      Epi<EP_PLAIN> e{Y, nullptr, nullptr, nullptr, nullptr, 1024, 0, 0};
      for (int rep = 0; rep < REP_GEMM * REP_M2L; ++rep) gemm_phase(lds, g, e); }
    if (ctx_alive) {
      Gemm g{(const bf16_t*)(ws + WS_HID), (const bf16_t*)(ws + WS_W2) + (size_t)layer * 4194304, 16384, 1024, 256, 4, 16, 0, 4096, 4096};
      Epi<EP_PLAIN> e{PART, nullptr, nullptr, nullptr, nullptr, 1024, 4, 16};
      for (int rep = 0; rep < REP_GEMM * REP_M2C; ++rep) gemm_phase(lds, g, e);
    }
    GSYNC();
    const bool lat_only_end = layer >= 2;
    const float* nmod = mod + (size_t)(layer + 1) * 30720;
    ln_pass(p, false, lmod + 5120, p.ln_g + (size_t)(layer * 2 + 1) * 1024, p.ln_b + (size_t)(layer * 2 + 1) * 1024, nmod + 0, nmod + 1024, layer == 3, lat_only_end, ctx_alive ? 16 : 0);
    if (layer < 3) { for (int rep = 0; rep < 1 + 10 * (REP_SYNC - 1); ++rep) GSYNC(); }
  }
}

extern "C" void kernel_launch(void* const* d_in, const int* in_sizes, int n_in, void* d_out, int out_size, void* d_ws, size_t ws_size, hipStream_t stream) {
  constexpr size_t kDynLds = 131072 + 256;
  static int grid_blocks = 0;
  if (!grid_blocks) {
    int dev = 0, cus = 0, per_cu = 0;
    (void)hipGetDevice(&dev);
    (void)hipDeviceGetAttribute(&cus, hipDeviceAttributeMultiprocessorCount, dev);
    (void)hipFuncSetAttribute((const void*)fwd_megakernel, hipFuncAttributeMaxDynamicSharedMemorySize, (int)kDynLds);
    (void)hipOccupancyMaxActiveBlocksPerMultiprocessor(&per_cu, (const void*)fwd_megakernel, 512, kDynLds);
    if (per_cu < 1) per_cu = 1;
    if (per_cu > 1) per_cu = 1;
    grid_blocks = cus * per_cu;
    if (ws_size < WS_END) fprintf(stderr, "kernel_launch: workspace too small: %zu < %zu\n", ws_size, (size_t)WS_END);
  }
  Params p{};
  p.x = (const float*)d_in[0]; p.c = (const float*)d_in[1]; p.ctx = (const float*)d_in[2]; p.c_ctx = (const float*)d_in[3];
  p.ada_w = (const float*)d_in[4]; p.ada_b = (const float*)d_in[5]; p.ln_g = (const float*)d_in[6]; p.ln_b = (const float*)d_in[7];
  p.w1 = (const float*)d_in[8]; p.w2 = (const float*)d_in[9]; p.w_in = (const float*)d_in[10]; p.conv_w = (const float*)d_in[11];
  p.lam_qk = (const float*)d_in[12]; p.subln_g = (const float*)d_in[13]; p.w_out_mix = (const float*)d_in[14]; p.w_out_f = (const float*)d_in[15];
  p.out = (float*)d_out; p.ws = (unsigned char*)d_ws;
  void* args[] = {&p};
  hipError_t e = hipLaunchCooperativeKernel((void*)fwd_megakernel, dim3(grid_blocks), dim3(512), args, kDynLds, stream);
  if (e != hipSuccess) fprintf(stderr, "cooperative launch failed: %s (grid %d)\n", hipGetErrorString(e), grid_blocks);
}
```
